# Optimizing an MI355X kernel written in HIP

```python
import math
import functools
import jax
import jax.numpy as jnp
from jax import lax
import numpy as np

D_MODEL = 1024
BATCH = 16
SEQ = 256
DEPTH = 4
DEC_BATCH = 4
DEC_SEQ = 1024
PAST_LEN = 256

GRID_W = 64
N_MIXERS = 4
N_MLSTM = (DEPTH + 3) // 4
N_CONV = (DEPTH + 2) // 4
N_POOL = (DEPTH + 1) // 4
N_FOURIER = DEPTH // 4
ML_HEADS = 8
ML_DQK = D_MODEL // 16
ML_DHV = D_MODEL // 8
ML_CHUNK = 64
ML_QK = ML_HEADS * ML_DQK
ML_V = ML_HEADS * ML_DHV
ML_IN = 2 * ML_QK + 2 * ML_V
N_GROUPS = 4
GROUP_W = D_MODEL // N_GROUPS
POOL_WINDOWS = (2, 4, 8, 16)
CONV_W = 3
D_FF = 4 * D_MODEL
ALPHA = (2.0 * DEPTH) ** 0.25
BETA = (8.0 * DEPTH) ** -0.25
LN_EPS = 1e-5
F32 = jnp.float32

kernel_name = "hybrid_mlstm_conv_pool_fourier_flow_step"


def layer_norm(x, g, b):
    xf = x.astype(F32)
    mu = jnp.mean(xf, axis=-1, keepdims=True)
    var = jnp.mean(jnp.square(xf - mu), axis=-1, keepdims=True)
    return ((xf - mu) * lax.rsqrt(var + LN_EPS) * g.astype(F32) + b.astype(F32)).astype(x.dtype)


def grid_pos_embed(rows, dtype):
    rr, cc = jnp.meshgrid(jnp.arange(rows, dtype=F32), jnp.arange(GRID_W, dtype=F32), indexing="ij")
    quarter = D_MODEL // 4
    omega = 1.0 / (10000.0 ** (jnp.arange(quarter, dtype=F32) / quarter))
    er = rr.reshape(-1, 1) * omega
    ec = cc.reshape(-1, 1) * omega
    return jnp.concatenate([jnp.sin(er), jnp.cos(er), jnp.sin(ec), jnp.cos(ec)], axis=-1).astype(dtype)


def mlstm_scan(q, k, v, ig, lf, C0, n0, m0):
    B, S, H, _ = q.shape
    L = math.gcd(S, ML_CHUNK)
    NC = S // L
    qc = q.reshape(B, NC, L, H, ML_DQK).transpose(1, 0, 3, 2, 4)
    kc = k.reshape(B, NC, L, H, ML_DQK).transpose(1, 0, 3, 2, 4)
    vc = v.reshape(B, NC, L, H, ML_DHV).transpose(1, 0, 3, 2, 4)
    ic = ig.reshape(B, NC, L, H).transpose(1, 0, 3, 2)
    fc = lf.reshape(B, NC, L, H).transpose(1, 0, 3, 2)
    mask = jnp.tril(jnp.ones((L, L), dtype=bool))

    def step(carry, inp):
        C, n, m = carry
        qq, kk, vv, ii, ff = inp
        b = jnp.cumsum(ff, axis=-1)
        dmat = jnp.where(mask, b[..., :, None] - b[..., None, :] + ii[..., None, :], -jnp.inf)
        inter = b + m[..., None]
        mt = jnp.maximum(inter, jnp.max(dmat, axis=-1))
        s = jnp.einsum("bhtd,bhsd->bhts", qq, kk) * jnp.exp(dmat - mt[..., None])
        a = jnp.exp(inter - mt)
        num = jnp.einsum("bhts,bhsv->bhtv", s, vv) + a[..., None] * jnp.einsum("bhtd,bhdv->bhtv", qq, C)
        den = jnp.sum(s, axis=-1) + a * jnp.einsum("bhtd,bhd->bht", qq, n)
        h = num / jnp.maximum(jnp.abs(den), jnp.exp(-mt))[..., None]
        m_new = mt[..., -1]
        b_last = b[..., -1]
        w = jnp.exp(b_last[..., None] - b + ii - m_new[..., None])
        dec = jnp.exp(b_last + m - m_new)
        C_new = dec[..., None, None] * C + jnp.einsum("bhs,bhsd,bhsv->bhdv", w, kk, vv)
        n_new = dec[..., None] * n + jnp.einsum("bhs,bhsd->bhd", w, kk)
        return (C_new, n_new, m_new), h

    (C, n, m), h = lax.scan(step, (C0, n0, m0), (qc, kc, vc, ic, fc))
    h = h.transpose(1, 0, 3, 2, 4).reshape(B, S, H, ML_DHV)
    return h, C, n, m


def mlstm_mixer(h, w_in, w_gate, b_gate, norm_g, w_out, C0, n0, m0):
    B, S, _ = h.shape
    q, k, v, o = jnp.split(h @ w_in, [ML_QK, 2 * ML_QK, 2 * ML_QK + ML_V], axis=-1)
    q = q.astype(F32).reshape(B, S, ML_HEADS, ML_DQK)
    k = k.astype(F32).reshape(B, S, ML_HEADS, ML_DQK) * (ML_DQK ** -0.5)
    v = v.astype(F32).reshape(B, S, ML_HEADS, ML_DHV)
    g = (h @ w_gate + b_gate).astype(F32).reshape(B, S, 2, 2, ML_HEADS)
    hs, Cs, ns, ms = [], [], [], []
    for d in range(2):
        seqs = (q, k, v, g[:, :, d, 0], jax.nn.log_sigmoid(g[:, :, d, 1]))
        if d == 1:
            seqs = tuple(jnp.flip(a, axis=1) for a in seqs)
        hd, Cd, nd, md = mlstm_scan(*seqs, C0[:, d].astype(F32), n0[:, d].astype(F32), m0[:, d].astype(F32))
        hs.append(jnp.flip(hd, axis=1) if d == 1 else hd)
        Cs.append(Cd)
        ns.append(nd)
        ms.append(md)
    hsum = hs[0] + hs[1]
    mu = jnp.mean(hsum, axis=-1, keepdims=True)
    var = jnp.mean(jnp.square(hsum - mu), axis=-1, keepdims=True)
    hn = (hsum - mu) * lax.rsqrt(var + LN_EPS) * norm_g.astype(F32).reshape(ML_HEADS, ML_DHV)
    y = (hn.reshape(B, S, ML_V) * jax.nn.sigmoid(o.astype(F32))).astype(h.dtype) @ w_out
    return y, jnp.stack(Cs, axis=1), jnp.stack(ns, axis=1), jnp.stack(ms, axis=1)


def shortconv_mixer(h, w_in, conv_w, w_out):
    bg, cg, u = jnp.split(h @ w_in, 3, axis=-1)
    cu = cg * u
    conv = lax.conv_general_dilated(cu, conv_w[:, None, :].astype(cu.dtype), window_strides=(1,),
                                    padding=((1, 1),), dimension_numbers=("NWC", "WIO", "NWC"),
                                    feature_group_count=D_MODEL)
    return (bg * conv) @ w_out


def pool_mixer(h, w, b, scale):
    B, S, _ = h.shape
    hg = h.astype(F32).reshape(B, S, N_GROUPS, GROUP_W)
    cs = jnp.pad(jnp.cumsum(hg, axis=1), ((0, 0), (1, 0), (0, 0), (0, 0)))
    t = jnp.arange(S)
    outs = []
    for gi, win in enumerate(POOL_WINDOWS):
        lo = jnp.clip(t - win // 2, 0, S)
        hi = jnp.clip(t + win - win // 2, 0, S)
        cs_g = cs[:, :, gi]
        mean = (cs_g[:, hi] - cs_g[:, lo]) / (hi - lo).astype(F32)[None, :, None]
        outs.append(mean - hg[:, :, gi])
    p = jnp.stack(outs, axis=2).astype(h.dtype)
    y = jnp.einsum("bsgc,gcd->bsgd", p, w) + b
    return y.reshape(B, S, D_MODEL) * scale


def fourier_mixer(h, w, b):
    B, S, _ = h.shape
    hg = h.astype(F32).reshape(B, S, N_GROUPS, GROUP_W)
    f = jnp.real(jnp.fft.fft2(hg, axes=(1, 3), norm="ortho"))
    return f.reshape(B, S, D_MODEL).astype(h.dtype) @ w + b


def sq_relu_mlp(h, w1, w2):
    return jnp.square(jax.nn.relu(h @ w1)) @ w2


def trunk(x, cond, st_C, st_n, st_m, w_mod, b_mod, ln_g, ln_b, mlp_w1, mlp_w2,
          ml_w_in, ml_w_gate, ml_b_gate, ml_norm_g, ml_w_out,
          sc_w_in, sc_conv_w, sc_w_out, pl_w, pl_b, pl_scale, ft_w_out, ft_b_out):
    s = jax.nn.silu(cond)
    fin_C, fin_n, fin_m = [], [], []
    for i in range(DEPTH):
        kind, j = i % N_MIXERS, i // N_MIXERS
        mod = (s @ w_mod[i] + b_mod[i])[:, None, :]
        sh1, sc1, g1, sh2, sc2, g2 = jnp.split(mod, 6, axis=-1)
        h = x * (1.0 + sc1) + sh1
        if kind == 0:
            y, Cf, nf, mf = mlstm_mixer(h, ml_w_in[j], ml_w_gate[j], ml_b_gate[j], ml_norm_g[j], ml_w_out[j],
                                        st_C[:, j], st_n[:, j], st_m[:, j])
            fin_C.append(Cf)
            fin_n.append(nf)
            fin_m.append(mf)
        elif kind == 1:
            y = shortconv_mixer(h, sc_w_in[j], sc_conv_w[j], sc_w_out[j])
        elif kind == 2:
            y = pool_mixer(h, pl_w[j], pl_b[j], pl_scale[j])
        else:
            y = fourier_mixer(h, ft_w_out[j], ft_b_out[j])
        x = layer_norm(ALPHA * x + g1 * y, ln_g[i, 0], ln_b[i, 0])
        h = x * (1.0 + sc2) + sh2
        x = layer_norm(ALPHA * x + g2 * sq_relu_mlp(h, mlp_w1[i], mlp_w2[i]), ln_g[i, 1], ln_b[i, 1])
    return x, jnp.stack(fin_C, axis=1), jnp.stack(fin_n, axis=1), jnp.stack(fin_m, axis=1)


def setup_inputs(seed: int = 0) -> dict:
    key = jax.random.key(seed)
    ks = jax.random.split(key, 26)
    D = D_MODEL

    def nrm(k, shape, scale):
        return jax.random.normal(k, shape, F32) * scale

    gate_noise = nrm(ks[15], (N_MLSTM, 2, 2, ML_HEADS), 0.1)
    gate_offset = jnp.array([0.0, 3.0], F32)[None, None, :, None]
    return {
        "x_prompt": nrm(ks[0], (BATCH, SEQ, D), 1.0),
        "x_sample": nrm(ks[1], (DEC_BATCH, DEC_SEQ, D), 1.0),
        "state_C": nrm(ks[2], (DEC_BATCH, N_MLSTM, 2, ML_HEADS, ML_DQK, ML_DHV), 0.1),
        "state_n": nrm(ks[3], (DEC_BATCH, N_MLSTM, 2, ML_HEADS, ML_DQK), 0.1),
        "state_m": nrm(ks[4], (DEC_BATCH, N_MLSTM, 2, ML_HEADS), 1.0),
        "c": nrm(ks[5], (DEC_BATCH, D), 1.0),
        "c_ctx": nrm(ks[6], (D,), 1.0),
        "w_mod": nrm(ks[7], (DEPTH, D, 6 * D), 0.5 * D ** -0.5),
        "b_mod": nrm(ks[8], (DEPTH, 6 * D), 0.02),
        "ln_g": 1.0 + nrm(ks[9], (DEPTH, 2, D), 0.02),
        "ln_b": nrm(ks[10], (DEPTH, 2, D), 0.02),
        "mlp_w1": nrm(ks[11], (DEPTH, D, D_FF), D ** -0.5),
        "mlp_w2": nrm(ks[12], (DEPTH, D_FF, D), BETA * D_FF ** -0.5),
        "ml_w_in": nrm(ks[13], (N_MLSTM, D, ML_IN), D ** -0.5),
        "ml_w_gate": nrm(ks[14], (N_MLSTM, D, 4 * ML_HEADS), D ** -0.5),
        "ml_b_gate": (gate_noise + gate_offset).reshape(N_MLSTM, 4 * ML_HEADS),
        "ml_norm_g": 1.0 + nrm(ks[16], (N_MLSTM, ML_V), 0.02),
        "ml_w_out": nrm(ks[17], (N_MLSTM, ML_V, D), BETA * ML_V ** -0.5),
        "sc_w_in": nrm(ks[18], (N_CONV, D, 3 * D), D ** -0.5),
        "sc_conv_w": nrm(ks[19], (N_CONV, CONV_W, D), CONV_W ** -0.5),
        "sc_w_out": nrm(ks[20], (N_CONV, D, D), BETA * D ** -0.5),
        "pl_w": nrm(ks[21], (N_POOL, N_GROUPS, GROUP_W, GROUP_W), BETA * GROUP_W ** -0.5),
        "pl_b": nrm(ks[22], (N_POOL, N_GROUPS, GROUP_W), 0.02),
        "pl_scale": 1.0 + nrm(ks[23], (N_POOL, D), 0.1),
        "ft_w_out": nrm(ks[24], (N_FOURIER, D, D), BETA * D ** -0.5),
        "ft_b_out": nrm(ks[25], (N_FOURIER, D), 0.02),
    }


def reference(x_prompt, x_sample, state_C, state_n, state_m, c, c_ctx,
              w_mod, b_mod, ln_g, ln_b, mlp_w1, mlp_w2,
              ml_w_in, ml_w_gate, ml_b_gate, ml_norm_g, ml_w_out,
              sc_w_in, sc_conv_w, sc_w_out, pl_w, pl_b, pl_scale, ft_w_out, ft_b_out):
    run = functools.partial(trunk, w_mod=w_mod, b_mod=b_mod, ln_g=ln_g, ln_b=ln_b,
                            mlp_w1=mlp_w1, mlp_w2=mlp_w2, ml_w_in=ml_w_in, ml_w_gate=ml_w_gate,
                            ml_b_gate=ml_b_gate, ml_norm_g=ml_norm_g, ml_w_out=ml_w_out,
                            sc_w_in=sc_w_in, sc_conv_w=sc_conv_w, sc_w_out=sc_w_out,
                            pl_w=pl_w, pl_b=pl_b, pl_scale=pl_scale, ft_w_out=ft_w_out, ft_b_out=ft_b_out)
    bp = x_prompt.shape[0]
    zC = jnp.zeros((bp, N_MLSTM, 2, ML_HEADS, ML_DQK, ML_DHV), F32)
    zn = jnp.zeros((bp, N_MLSTM, 2, ML_HEADS, ML_DQK), F32)
    zm = jnp.zeros((bp, N_MLSTM, 2, ML_HEADS), F32)
    y_prompt, new_C, new_n, new_m = run(x_prompt, c_ctx[None, :], zC, zn, zm)
    rows = x_sample.shape[1] // GRID_W
    xs = x_sample + grid_pos_embed(rows, x_sample.dtype)[None]
    y_sample, _, _, _ = run(xs, c, state_C, state_n, state_m)
    return (y_prompt, y_sample, new_C.astype(x_prompt.dtype), new_n.astype(x_prompt.dtype), new_m.astype(x_prompt.dtype))
```

```cpp
#include <hip/hip_runtime.h>
#include <cstdio>
#include <cstdint>

#ifndef MK_ONE_LAUNCH
#define MK_ONE_LAUNCH 0
#endif

#define LAS __attribute__((address_space(3)))
#define GAS __attribute__((address_space(1)))
typedef unsigned short bf16_t;
typedef short bf16x8 __attribute__((ext_vector_type(8)));
typedef float f32x4 __attribute__((ext_vector_type(4)));
typedef float f32x2 __attribute__((ext_vector_type(2)));
typedef unsigned u32x4 __attribute__((ext_vector_type(4)));
typedef unsigned u32x2 __attribute__((ext_vector_type(2)));
#define DI __device__ __forceinline__

constexpr int D = 1024, MTOK = 8192, NCTX = 4096, FF = 4096, NHEAD = 8, DQK = 64, DHV = 128;
constexpr int MLN = 3328;
constexpr int NCOND = 5, NMOD = 6 * D;
constexpr float ALPHA = 1.6817928305074292f;
constexpr float LN_EPS = 1e-5f;
constexpr int NWAVES = 8, NTHR = 512;
constexpr int LDS_BYTES = 147456;

constexpr size_t MiB = 1u << 20;
constexpr size_t WS_CTL = 0, CTL_ZERO_BYTES = 64 * 1024;
constexpr size_t WS_MOD = 1 * MiB;
constexpr size_t WS_WT_MLIN = 2 * MiB;
constexpr size_t WS_WT_MLOUT = 9 * MiB;
constexpr size_t WS_WT_SCIN = 11 * MiB;
constexpr size_t WS_WT_SCOUT = 17 * MiB;
constexpr size_t WS_WT_PL = 19 * MiB;
constexpr size_t WS_WT_FT = 20 * MiB;
constexpr size_t WS_WC = 22 * MiB;
constexpr size_t WS_T256 = 22 * MiB + 256 * 1024;
constexpr size_t WS_T1024 = 22 * MiB + 512 * 1024;
constexpr size_t WS_WT_W1 = 27 * MiB;
constexpr size_t WS_WT_W2 = 59 * MiB;
constexpr size_t WS_H = 91 * MiB;
constexpr size_t WS_HS = 107 * MiB;
constexpr size_t WS_Y = 123 * MiB;
constexpr size_t WS_QKVO = 187 * MiB;
constexpr size_t WS_H1 = 235 * MiB;
constexpr size_t WS_GATES = 299 * MiB;
constexpr size_t WS_L = 300 * MiB;
constexpr size_t WS_NL = 364 * MiB;
constexpr size_t WS_NINIT = 364 * MiB + 512 * 1024;
constexpr size_t WS_MLOC = 365 * MiB;
constexpr size_t WS_BLAST = 365 * MiB + 8192;
constexpr size_t WS_MINIT = 365 * MiB + 16384;
constexpr size_t WS_END = 366 * MiB;

constexpr size_t OUT_YS = 0, OUT_NEWC = 8388608, OUT_NEWN = 10485760, OUT_NEWM = 10502144;

DI float bf2f(unsigned short b) { return __uint_as_float((unsigned)b << 16); }
DI unsigned f2bf(float f) { unsigned u = __float_as_uint(f); return (u + 0x7fffu + ((u >> 16) & 1u)) >> 16; }
DI unsigned pk2(float lo, float hi) { return f2bf(lo) | (f2bf(hi) << 16); }
DI float sigmoidf_(float x) { return 1.0f / (1.0f + __expf(-x)); }

namespace pg8 {
constexpr int BM = 256, BK = 64, HALF = 128, HTB = HALF * BK * 2, STAGE_BYTES = 8 * HTB;
__host__ __device__ __forceinline__ int lds_byte(int r, int c) { const int st = (r >> 4) * 2 + (c >> 5), rr = r & 15, cc = c & 31, ob = rr * 64 + cc * 2; return st * 1024 + (ob ^ (((ob >> 9) & 1) << 5)); }
__host__ __device__ __forceinline__ void stage_rc(int b, int& R, int& C) { const int st = b / 1024, sb = b % 1024, swz = sb ^ (((sb >> 9) & 1) << 5); R = (st >> 1) * 16 + swz / 64; C = (st & 1) * 32 + (swz % 64) / 2; }

struct Unit { const char* a; const char* b; int nt, pm, pn, aux; };

template <class Epi, class Sched>
DI void gemm_phase(LAS unsigned char* lds, const int tid, const int lda, const int ldb, const Sched& S, const Epi& E) {
    const int wid = __builtin_amdgcn_readfirstlane(tid >> 6), lane = tid & 63, wr = wid >> 2, wc = wid & 3, fr = lane & 15, fq = lane >> 4;
    unsigned voffA[2], voffB[2];
#pragma unroll
    for (int i = 0; i < 2; ++i) { int R, C; stage_rc(tid * 16 + i * 8192, R, C); voffA[i] = (unsigned)(R * lda + C) * 2u; voffB[i] = (unsigned)(R * ldb + C) * 2u; }
    const size_t kstep = (size_t)(BK * 2);
    const size_t hstepA = (size_t)HALF * lda * 2, hstepB = (size_t)HALF * ldb * 2;
    const unsigned ldsw = (unsigned)wid * 1024u;
    const int aoff = lds_byte(wr * 64 + fr, fq * 8), boff = lds_byte(wc * 32 + fr, fq * 8);
#define PG8_SA(b, h) (((b) * 2 + (h)) * HTB)
#define PG8_SB(b, h) ((4 + (b) * 2 + (h)) * HTB)
#define PG8_STAGE(bufoff, gbase, voff) do { _Pragma("unroll") for (int _i = 0; _i < 2; ++_i) \
        __builtin_amdgcn_global_load_lds((const unsigned*)((const char*)(gbase) + (voff)[_i]), (LAS unsigned*)(lds + (bufoff) + ldsw + _i * 8192), 16, 0, 0); } while (0)
#define PG8_LDA(dst, b, h) do { _Pragma("unroll") for (int m = 0; m < 4; ++m) _Pragma("unroll") for (int k = 0; k < 2; ++k) dst[m][k] = *(const LAS bf16x8*)(lds + PG8_SA(b, h) + aoff + m * 2048 + k * 1024); } while (0)
#define PG8_LDB(dst, b, h) do { _Pragma("unroll") for (int n = 0; n < 2; ++n) _Pragma("unroll") for (int k = 0; k < 2; ++k) dst[n][k] = *(const LAS bf16x8*)(lds + PG8_SB(b, h) + boff + n * 2048 + k * 1024); } while (0)
#define PG8_MMA(ai, bj, At, Bt) do { __builtin_amdgcn_s_setprio(1); _Pragma("unroll") for (int m = 0; m < 4; ++m) _Pragma("unroll") for (int n = 0; n < 2; ++n) _Pragma("unroll") for (int k = 0; k < 2; ++k) \
        acc[ai][bj][m][n] = __builtin_amdgcn_mfma_f32_16x16x32_bf16(Bt[n][k], At[m][k], acc[ai][bj][m][n], 0, 0, 0); __builtin_amdgcn_s_setprio(0); } while (0)
#define PG8_WAIT_V(n) asm volatile("s_waitcnt vmcnt(" #n ")" ::: "memory")
#define PG8_WAIT_L(n) asm volatile("s_waitcnt lgkmcnt(" #n ")" ::: "memory")
#define PG8_BAR __builtin_amdgcn_s_barrier()
#define PG8_SCHED __builtin_amdgcn_sched_barrier(0)
    Unit cur, nxt; int ui = 0;
    if (!S.next(0, cur)) return;
    f32x4 acc[2][2][4][2];
#pragma unroll
    for (int a = 0; a < 2; ++a)
#pragma unroll
        for (int b = 0; b < 2; ++b)
#pragma unroll
            for (int m = 0; m < 4; ++m)
#pragma unroll
                for (int n = 0; n < 2; ++n) acc[a][b][m][n] = (f32x4){0.f, 0.f, 0.f, 0.f};
    bf16x8 At[4][2], B0[2][2], B1[2][2];
    const char* cA = cur.a; const char* cB = cur.b;
    PG8_STAGE(PG8_SB(0, 0), cB, voffB); PG8_STAGE(PG8_SB(0, 1), cB + hstepB, voffB); PG8_STAGE(PG8_SA(0, 0), cA, voffA); PG8_STAGE(PG8_SA(0, 1), cA + hstepA, voffA);
    if (wr == 1) PG8_BAR;
    PG8_WAIT_V(2); PG8_BAR;
    PG8_STAGE(PG8_SB(1, 0), cB + kstep, voffB); PG8_STAGE(PG8_SA(1, 0), cA + kstep, voffA); PG8_STAGE(PG8_SB(1, 1), cB + hstepB + kstep, voffB);
    PG8_WAIT_V(6); PG8_BAR;
    for (;;) {
        const bool has_next = S.next(ui + 1, nxt);
        const char* nA = has_next ? nxt.a : cA; const char* nB = has_next ? nxt.b : cB;
        const int nt = cur.nt;
        for (int t = 0; t < nt; t += 2) {
            const bool last = (t == nt - 2);
            const char* a1 = cA + (size_t)(t + 1) * kstep;
            const char* a2 = last ? nA : cA + (size_t)(t + 2) * kstep; const char* b2 = last ? nB : cB + (size_t)(t + 2) * kstep;
            const char* a3 = a2 + kstep; const char* b3 = b2 + kstep;
            PG8_LDB(B0, 0, 0); PG8_LDB(B1, 0, 1); PG8_SCHED; PG8_LDA(At, 0, 0); PG8_STAGE(PG8_SA(1, 1), a1 + hstepA, voffA);
            PG8_WAIT_V(8); PG8_WAIT_L(0); PG8_BAR; PG8_MMA(0, 0, At, B0); PG8_MMA(0, 1, At, B1); PG8_BAR; PG8_SCHED;
            PG8_LDA(At, 0, 1); PG8_STAGE(PG8_SB(0, 0), b2, voffB); PG8_STAGE(PG8_SB(0, 1), b2 + hstepB, voffB); PG8_STAGE(PG8_SA(0, 0), a2, voffA);
            PG8_WAIT_V(8); PG8_WAIT_L(0); PG8_BAR; PG8_MMA(1, 0, At, B0); PG8_MMA(1, 1, At, B1); PG8_BAR; PG8_SCHED;
            PG8_LDB(B0, 1, 0); PG8_LDB(B1, 1, 1); PG8_SCHED; PG8_LDA(At, 1, 0); PG8_STAGE(PG8_SA(0, 1), a2 + hstepA, voffA);
            PG8_WAIT_V(8); PG8_WAIT_L(0); PG8_BAR; PG8_MMA(0, 0, At, B0); PG8_MMA(0, 1, At, B1); PG8_BAR; PG8_SCHED;
            PG8_LDA(At, 1, 1); PG8_STAGE(PG8_SB(1, 0), b3, voffB); PG8_STAGE(PG8_SB(1, 1), b3 + hstepB, voffB); PG8_STAGE(PG8_SA(1, 0), a3, voffA);
            PG8_WAIT_V(8); PG8_WAIT_L(0); PG8_BAR; PG8_MMA(1, 0, At, B0); PG8_MMA(1, 1, At, B1); PG8_BAR; PG8_SCHED;
        }
        if (wr == 0) PG8_BAR;
        E(acc, cur, wr, wc, fr, fq);
        if (!has_next) break;
#pragma unroll
        for (int a = 0; a < 2; ++a)
#pragma unroll
            for (int b = 0; b < 2; ++b)
#pragma unroll
                for (int m = 0; m < 4; ++m)
#pragma unroll
                    for (int n = 0; n < 2; ++n) acc[a][b][m][n] = (f32x4){0.f, 0.f, 0.f, 0.f};
        cur = nxt; cA = nA; cB = nB; ++ui;
        if (wr == 1) PG8_BAR;
    }
    PG8_WAIT_V(0);
    PG8_BAR;
#undef PG8_SA
#undef PG8_SB
#undef PG8_STAGE
#undef PG8_LDA
#undef PG8_LDB
#undef PG8_MMA
#undef PG8_WAIT_V
#undef PG8_WAIT_L
#undef PG8_BAR
#undef PG8_SCHED
}
}

typedef GAS unsigned gu32;
#define RLX_AGENT __ATOMIC_RELAXED, __HIP_MEMORY_SCOPE_AGENT
#define XB_TMO      128
#define XB_XCNT(j)  (256  + 64 * (j))
#define XB_XSUB(j)  (1280 + 64 * (j))
#define XB_XGEN(j)  (2304 + 64 * (j))
#define XB_TOP      3328
#define XB_TOPGEN   3392
#define XCD_BAR_WORDS 3456
#define XB_SPIN_CAP (1u << 20)
DI unsigned xb_ld(unsigned* p)              { return __hip_atomic_load(p, __ATOMIC_RELAXED, __HIP_MEMORY_SCOPE_AGENT); }
DI unsigned xb_add(unsigned* p, unsigned v) { return __hip_atomic_fetch_add(p, v, __ATOMIC_RELAXED, __HIP_MEMORY_SCOPE_AGENT); }
DI unsigned xb_xcc_id() { return (unsigned)__builtin_amdgcn_s_getreg((3 << 11) | 20) & 0xFu; }
#define XB_SPIN(cond, bar) do { unsigned _sp = 0; while (cond) { __builtin_amdgcn_s_sleep(1); \
    if ((++_sp & 255u) == 0u) { if (xb_ld(&(bar)[XB_TMO])) break; if (_sp > XB_SPIN_CAP) { atomicAdd(&(bar)[XB_TMO], 1u); break; } } } } while (0)
struct XcdBarrier { unsigned* bar; unsigned x; volatile LAS unsigned* st; };
DI XcdBarrier xcd_barrier_post(unsigned* bar, volatile LAS unsigned* st) {
    XcdBarrier b; b.bar = bar; b.x = xb_xcc_id(); b.st = st;
    if (threadIdx.x == 0) (void)xb_add(&bar[XB_XCNT(b.x)], 1u);
    return b;
}
DI void xcd_barrier_complete(unsigned* bar, unsigned x, unsigned& nloc, unsigned& nx) {
    const unsigned G = gridDim.x * gridDim.y * gridDim.z;
    unsigned sum, cnt, mine, sp = 0u;
    for (;;) {
        sum = 0u; cnt = 0u; mine = 0u;
#pragma unroll
        for (unsigned j = 0; j < 16; ++j) { const unsigned c = xb_ld(&bar[XB_XCNT(j)]); sum += c; cnt += (c > 0u) ? 1u : 0u; mine = (j == x) ? c : mine; }
        if (sum == G) break;
        __builtin_amdgcn_s_sleep(1);
        if ((++sp & 255u) == 0u) { if (xb_ld(&bar[XB_TMO])) break; if (sp > XB_SPIN_CAP) { atomicAdd(&bar[XB_TMO], 1u); break; } }
    }
    nloc = mine > 0u ? mine : 1u; nx = cnt > 0u ? cnt : 1u;
}
DI void xcd_barrier(const XcdBarrier& b) {
    asm volatile("s_waitcnt vmcnt(0)" ::: "memory");
    __syncthreads();
    if (threadIdx.x == 0) {
        unsigned* bar = b.bar;
        __builtin_amdgcn_s_waitcnt(0);
        unsigned nloc = b.st[0], nx = b.st[1];
        if (nloc == 0u) { xcd_barrier_complete(bar, b.x, nloc, nx); b.st[0] = nloc; b.st[1] = nx; }
        const unsigned old = xb_add(&bar[XB_XSUB(b.x)], 1u);
        const unsigned gen = old / nloc;
        if (old + 1u == (gen + 1u) * nloc) {
            __builtin_amdgcn_fence(__ATOMIC_RELEASE, "agent");
            asm volatile("s_waitcnt vmcnt(0)" ::: "memory");
            const unsigned og = xb_add(&bar[XB_TOP], 1u);
            const unsigned tg = og / nx;
            if (og + 1u == (tg + 1u) * nx) xb_add(&bar[XB_TOPGEN], 1u);
            else XB_SPIN(xb_ld(&bar[XB_TOPGEN]) == tg, bar);
            __builtin_amdgcn_fence(__ATOMIC_ACQUIRE, "agent");
            xb_add(&bar[XB_XGEN(b.x)], 1u);
            asm volatile("s_waitcnt vmcnt(0)" ::: "memory");
        } else {
            XB_SPIN(xb_ld(&bar[XB_XGEN(b.x)]) == gen, bar);
            __builtin_amdgcn_fence(__ATOMIC_ACQUIRE, "agent");
            asm volatile("s_waitcnt vmcnt(0)" ::: "memory");
        }
    }
    __syncthreads();
}

struct Args { const float* in[26]; float* out; unsigned char* ws; int ph_lo, ph_hi; };

struct Frame {
    LAS unsigned char* lds;
    int tid, lane, wave, G, bid;
    const float* const* in;
    float* out; unsigned char* ws;
};

DI int row_cond(int row) { return row < NCTX ? 0 : 1 + ((row - NCTX) >> 10); }

enum { K_STD = 0, K_SPLIT2, K_POOL, K_F1, K_F2C, K_F2L };
enum { E_ML = 0, E_BF16, E_RELU2, E_F32SPLIT, E_POOL, E_F1, E_F2 };

template <int SKIND> struct Sched {
    int G, c, n_units, nN, nt;
    const bf16_t* A; const bf16_t* Bt; int lda, ldb;
    DI static void std_tile(int L, int nM, int nN, int& pm, int& pn) {
        const int nwg = nM * nN; int wgid = L;
        { const int q = nwg / 8, r = nwg % 8, xcd = wgid % 8, off = wgid / 8; wgid = (xcd < r ? xcd * (q + 1) : r * (q + 1) + (xcd - r) * q) + off; }
        const int nig = 8 * nN, gid = wgid / nig, fm = gid * 8, gsz = (nM - fm) < 8 ? (nM - fm) : 8;
        pm = fm + ((wgid % nig) % gsz); pn = (wgid % nig) / gsz;
    }
    DI bool next(int i, pg8::Unit& u) const {
        const int L = i * G + c; if (L >= n_units) return false;
        int pm = 0, pn = 0; u.aux = 0; u.nt = nt;
        if constexpr (SKIND == K_STD) { std_tile(L, 32, nN, pm, pn);
            u.a = (const char*)(A + (size_t)pm * 256 * lda); u.b = (const char*)(Bt + (size_t)pn * 256 * ldb); }
        else if constexpr (SKIND == K_SPLIT2) { const int ks = L >> 7; std_tile(L & 127, 32, 4, pm, pn);
            u.a = (const char*)(A + (size_t)pm * 256 * lda + (size_t)ks * nt * 64); u.b = (const char*)(Bt + (size_t)pn * 256 * ldb + (size_t)ks * nt * 64); u.aux = ks; }
        else if constexpr (SKIND == K_POOL) { const int g = L & 3; pm = L >> 2; pn = g;
            u.a = (const char*)(A + (size_t)pm * 256 * lda + g * 256); u.b = (const char*)(Bt + (size_t)g * 65536); }
        else if constexpr (SKIND == K_F1) { const int tt = L >> 3, r = L & 7, g = r >> 1, part = r & 1; pm = part; pn = tt; u.aux = g;
            u.a = (const char*)(A + (size_t)part * 256 * 256); u.b = (const char*)(Bt + (size_t)tt * 256 * ldb + g * 256); }
        else if constexpr (SKIND == K_F2C) { const int b = L >> 2; pn = L & 3; pm = b; u.aux = 0;
            u.a = (const char*)A; u.b = (const char*)(Bt + (size_t)b * (1024 * 512) + (size_t)pn * 256 * 512); }
        else { const int b = L >> 4, pml = (L >> 2) & 3; pn = L & 3; pm = 16 + b * 4 + pml; u.aux = 1;
            u.a = (const char*)(A + (size_t)pml * 256 * 2048); u.b = (const char*)(Bt + (size_t)b * (1024 * 2048) + (size_t)pn * 256 * 2048); }
        u.pm = pm; u.pn = pn; return true;
    }
};

template <int EKIND> struct Epi {
    bf16_t* ob; float* of; int ldc;
    const float* p0; const float* p1;
    template <int KIND> DI void store4(const pg8::Unit& u, int row, int col, f32x4 v) const {
        if (KIND == E_ML) {
            if (col < 3072) {
                if (col >= 512 && col < 1024) v = v * 0.125f;
                u32x2 w; w.x = pk2(v[0], v[1]); w.y = pk2(v[2], v[3]);
                *(u32x2*)(ob + (size_t)row * 3072 + col) = w;
            } else {
                const int cc = col - 3072;
                if (cc < 32) {
                    f32x4 g = v + *(const f32x4*)(p0 + cc);
                    if ((cc >> 3) & 1) {
#pragma unroll
                        for (int j = 0; j < 4; ++j) { const float x = g[j]; g[j] = fminf(x, 0.f) - log1pf(expf(-fabsf(x))); }
                    }
                    *(f32x4*)(of + (size_t)row * 32 + cc) = g;
                }
            }
        } else if (KIND == E_BF16) {
            u32x2 w; w.x = pk2(v[0], v[1]); w.y = pk2(v[2], v[3]);
            *(u32x2*)(ob + (size_t)row * ldc + col) = w;
        } else if (KIND == E_RELU2) {
#pragma unroll
            for (int j = 0; j < 4; ++j) { const float r = fmaxf(v[j], 0.f); v[j] = r * r; }
            u32x2 w; w.x = pk2(v[0], v[1]); w.y = pk2(v[2], v[3]);
            *(u32x2*)(ob + (size_t)row * ldc + col) = w;
        } else if (KIND == E_F32SPLIT) {
            *(f32x4*)(of + (size_t)u.aux * ((size_t)MTOK * D) + (size_t)row * D + col) = v;
        } else if (KIND == E_POOL) {
            const f32x4 b = *(const f32x4*)(p0 + col), s = *(const f32x4*)(p1 + col);
            *(f32x4*)(of + (size_t)row * D + col) = (v + b) * s;
        } else if (KIND == E_F1) {
            const int part = row >> 8, cp = row & 255, n = u.aux * 256 + cp;
            size_t dst;
            if (col < NCTX) { const int b = col >> 8, s = col & 255; dst = (size_t)b * (1024 * 512) + (size_t)n * 512 + part * 256 + s; }
            else { const int t = col - NCTX, b = t >> 10, s = t & 1023; dst = (size_t)16 * (1024 * 512) + (size_t)b * (1024 * 2048) + (size_t)n * 2048 + part * 1024 + s; }
            u32x2 w; w.x = pk2(v[0], v[1]); w.y = pk2(v[2], v[3]);
            *(u32x2*)(ob + dst) = w;
        } else {
            const float sc = u.aux ? (1.0f / 512.0f) : (1.0f / 256.0f);
            v = v * sc;
            u32x2 w; w.x = pk2(v[0], v[1]); w.y = pk2(v[2], v[3]);
            *(u32x2*)(ob + (size_t)row * D + col) = w;
        }
    }
    template <int KIND> DI void run(const f32x4 (&acc)[2][2][4][2], const pg8::Unit& u, int wr, int wc, int fr, int fq) const {
        const int row0 = u.pm * 256 + wr * 64 + fr, col0 = u.pn * 256 + wc * 32 + 4 * fq;
#pragma unroll
        for (int ai = 0; ai < 2; ++ai)
#pragma unroll
            for (int m = 0; m < 4; ++m)
#pragma unroll
                for (int bj = 0; bj < 2; ++bj)
#pragma unroll
                    for (int n = 0; n < 2; ++n) store4<KIND>(u, row0 + ai * 128 + m * 16, col0 + bj * 128 + n * 16, acc[ai][bj][m][n]);
    }
    DI void operator()(const f32x4 (&acc)[2][2][4][2], const pg8::Unit& u, int wr, int wc, int fr, int fq) const { run<EKIND>(acc, u, wr, wc, fr, fq); }
};

#ifdef NAIVE_GEMM
template <int SKIND, int EKIND> DI void gemm_run(Frame& F, const Sched<SKIND>& S, const Epi<EKIND>& E) {
    pg8::Unit u;
    for (int i = 0; S.next(i, u); ++i) {
        const bf16_t* A = (const bf16_t*)u.a; const bf16_t* B = (const bf16_t*)u.b; const int K = u.nt * 64;
        for (int e = F.tid; e < 256 * 64; e += NTHR) {
            const int r = e >> 6, c4 = (e & 63) * 4;
            f32x4 acc = (f32x4){0.f, 0.f, 0.f, 0.f};
            for (int k = 0; k < K; ++k) { const float a = bf2f(A[(size_t)r * S.lda + k]);
#pragma unroll
                for (int j = 0; j < 4; ++j) acc[j] += a * bf2f(B[(size_t)(c4 + j) * S.ldb + k]); }
            E.template store4<EKIND>(u, u.pm * 256 + r, u.pn * 256 + c4, acc);
        }
    }
}
#else
template <int SKIND, int EKIND> DI void gemm_run(Frame& F, const Sched<SKIND>& S, const Epi<EKIND>& E) { pg8::gemm_phase<Epi<EKIND>, Sched<SKIND>>(F.lds, F.tid, S.lda, S.ldb, S, E); }
#endif

DI float wave_sum(float v) {
#pragma unroll
    for (int o = 1; o < 64; o <<= 1) v += __shfl_xor(v, o);
    return v;
}
DI float wave_max(float v) {
#pragma unroll
    for (int o = 1; o < 64; o <<= 1) v = fmaxf(v, __shfl_xor(v, o));
    return v;
}
DI void p0_transpose_item(const float* W, int K, int N, bf16_t* WT, int row_off, LAS float* scr, int item, int lane) {
    const int nblk = N / 32, kb = item / nblk, nb = item % nblk, k0 = 64 * kb, n0 = 32 * nb;
#pragma unroll 8
    for (int i = 0; i < 32; ++i) { const int kk = 2 * i + (lane >> 5); scr[kk * 33 + (lane & 31)] = W[(size_t)(k0 + kk) * N + n0 + (lane & 31)]; }
    asm volatile("s_waitcnt lgkmcnt(0)" ::: "memory");
    const int c = lane & 7;
#pragma unroll
    for (int j = 0; j < 4; ++j) { const int n = (lane >> 3) + 8 * j; const LAS float* s = scr + (8 * c) * 33 + n;
        u32x4 o; o.x = pk2(s[0 * 33], s[1 * 33]); o.y = pk2(s[2 * 33], s[3 * 33]); o.z = pk2(s[4 * 33], s[5 * 33]); o.w = pk2(s[6 * 33], s[7 * 33]);
        *(u32x4*)(WT + (size_t)(row_off + n0 + n) * K + k0 + 8 * c) = o; }
    asm volatile("s_waitcnt lgkmcnt(0)" ::: "memory");
}

DI void phase_prologue_a(Frame& F) {
    const float* const* in = F.in;
    {
        LAS float* sl = (LAS float*)(F.lds + 71680);
        LAS f32x4* red = (LAS f32x4*)(F.lds + 92160);
        for (int e = F.tid; e < NCOND * D; e += NTHR) { const int cd = e >> 10, k = e & 1023; const float c = cd == 0 ? in[6][k] : in[5][(cd - 1) * D + k]; sl[e] = c / (1.0f + expf(-c)); }
        __syncthreads();
        float* MOD = (float*)(F.ws + WS_MOD);
        for (int item = F.bid; item < 256; item += F.G) {
            const int colg = item * 96, l = colg / NMOD, n0 = colg % NMOD;
            const int cg = F.tid % 24, kg = F.tid / 24;
            f32x4 acc[NCOND];
#pragma unroll
            for (int c = 0; c < NCOND; ++c) acc[c] = (f32x4){0.f, 0.f, 0.f, 0.f};
            if (kg < 21) {
                const float* wp = in[7] + (size_t)l * D * NMOD + n0 + cg * 4;
#pragma unroll 7
                for (int k = kg; k < D; k += 21) { const f32x4 w = *(const f32x4*)(wp + (size_t)k * NMOD);
#pragma unroll
                    for (int c = 0; c < NCOND; ++c) acc[c] += w * sl[c * D + k]; }
#pragma unroll
                for (int c = 0; c < NCOND; ++c) red[(kg * NCOND + c) * 24 + cg] = acc[c];
            }
            __syncthreads();
            if (F.tid < NCOND * 24) { const int c = F.tid / 24, g = F.tid % 24; f32x4 s = *(const f32x4*)(in[8] + (size_t)l * NMOD + n0 + g * 4);
                for (int q = 0; q < 21; ++q) s += red[(q * NCOND + c) * 24 + g];
                *(f32x4*)(MOD + ((size_t)l * NCOND + c) * NMOD + n0 + g * 4) = s; }
            __syncthreads();
        }
    }
    __syncthreads();
    {
        LAS float* scr = (LAS float*)(F.lds + F.wave * 8704);
        const int gw = F.bid * NWAVES + F.wave, NGW = F.G * NWAVES;
        bf16_t* wt_mlin = (bf16_t*)(F.ws + WS_WT_MLIN);
        for (int it = gw; it < 21136; it += NGW) {
            int r = it;
            if (r < 1536) { p0_transpose_item(in[13], 1024, 3072, wt_mlin, 0, scr, r, F.lane); continue; } r -= 1536;
            if (r < 16)   { p0_transpose_item(in[14], 1024, 32, wt_mlin, 3072, scr, r, F.lane); continue; } r -= 16;
            if (r < 512)  { p0_transpose_item(in[17], 1024, 1024, (bf16_t*)(F.ws + WS_WT_MLOUT), 0, scr, r, F.lane); continue; } r -= 512;
            if (r < 1536) { p0_transpose_item(in[18], 1024, 3072, (bf16_t*)(F.ws + WS_WT_SCIN), 0, scr, r, F.lane); continue; } r -= 1536;
            if (r < 512)  { p0_transpose_item(in[20], 1024, 1024, (bf16_t*)(F.ws + WS_WT_SCOUT), 0, scr, r, F.lane); continue; } r -= 512;
            if (r < 512)  { p0_transpose_item(in[24], 1024, 1024, (bf16_t*)(F.ws + WS_WT_FT), 0, scr, r, F.lane); continue; } r -= 512;
            if (r < 128)  { const int g = r >> 5; p0_transpose_item(in[21] + (size_t)g * 65536, 256, 256, (bf16_t*)(F.ws + WS_WT_PL) + (size_t)g * 65536, 0, scr, r & 31, F.lane); continue; } r -= 128;
            if (r < 8192) { const int l = r >> 11; p0_transpose_item(in[11] + (size_t)l * D * FF, 1024, 4096, (bf16_t*)(F.ws + WS_WT_W1) + (size_t)l * D * FF, 0, scr, r & 2047, F.lane); continue; } r -= 8192;
            { const int l = r >> 11; p0_transpose_item(in[12] + (size_t)l * D * FF, 4096, 1024, (bf16_t*)(F.ws + WS_WT_W2) + (size_t)l * D * FF, 0, scr, r & 2047, F.lane); }
        }
        const int gt = F.bid * NTHR + F.tid, NGT = F.G * NTHR;
        u32x4* z = (u32x4*)(wt_mlin + (size_t)3104 * 1024);
        for (int i = gt; i < 224 * 1024 / 8; i += NGT) z[i] = (u32x4){0u, 0u, 0u, 0u};
        bf16_t* WC = (bf16_t*)(F.ws + WS_WC); bf16_t* T256 = (bf16_t*)(F.ws + WS_T256); bf16_t* T1024 = (bf16_t*)(F.ws + WS_T1024);
        for (int i = gt; i < 512 * 256; i += NGT) {
            { const int row = i >> 8, k = i & 255, part = row >> 8, c = row & 255; const int r = (c * k) & 255; float sn, cs; sincospif((float)r * (2.0f / 256.0f), &sn, &cs); WC[i] = (bf16_t)f2bf(part ? sn : cs); }
            { const int sp = i >> 9, col = i & 511, part = col >> 8, s = col & 255; const int r = (sp * s) & 255; float sn, cs; sincospif((float)r * (2.0f / 256.0f), &sn, &cs); T256[i] = (bf16_t)f2bf(part ? -sn : cs); }
        }
        for (int i = gt; i < 1024 * 2048; i += NGT) { const int sp = i >> 11, col = i & 2047, part = col >> 10, s = col & 1023; const int r = (sp * s) & 1023; float sn, cs; sincospif((float)r * (2.0f / 1024.0f), &sn, &cs); T1024[i] = (bf16_t)f2bf(part ? -sn : cs); }
    }
}

DI void phase_prologue_b(Frame& F) {
    const int gw = F.bid * NWAVES + F.wave, NGW = F.G * NWAVES;
    const float* MOD = (const float*)(F.ws + WS_MOD);
    bf16_t* H = (bf16_t*)(F.ws + WS_H);
    for (int row = gw; row < MTOK; row += NGW) {
        const int cd = row_cond(row);
        const float* src = row < NCTX ? F.in[0] + (size_t)row * D : F.in[1] + (size_t)(row - NCTX) * D;
        const float* md = MOD + (size_t)cd * NMOD;
        int gr = 0, gc = 0; if (row >= NCTX) { const int t = (row - NCTX) & 1023; gr = t >> 6; gc = t & 63; }
#pragma unroll
        for (int j = 0; j < 4; ++j) {
            const int col = 4 * F.lane + 256 * j;
            f32x4 v = *(const f32x4*)(src + col);
            if (row >= NCTX) {
                const int quarter = j;
#pragma unroll
                for (int e = 0; e < 4; ++e) { const int jj = (col + e) & 255; const float omega = expf(-(float)jj * (9.210340371976184f / 256.0f));
                    const float arg = (float)(quarter < 2 ? gr : gc) * omega; v[e] += (quarter & 1) ? cosf(arg) : sinf(arg); }
            }
            *(f32x4*)(F.out + (size_t)row * D + col) = v;
            const f32x4 sh = *(const f32x4*)(md + col), sc = *(const f32x4*)(md + D + col);
            const f32x4 h = v * (sc + 1.0f) + sh;
            u32x2 w; w.x = pk2(h[0], h[1]); w.y = pk2(h[2], h[3]);
            *(u32x2*)(H + (size_t)row * D + col) = w;
        }
    }
}

DI void phase_ln(Frame& F, int l, int sub, int nsplit, const float* bias) {
    const int gw = F.bid * NWAVES + F.wave, NGW = F.G * NWAVES;
    const float* MOD = (const float*)(F.ws + WS_MOD);
    const float* Y = (const float*)(F.ws + WS_Y);
    bf16_t* H = (bf16_t*)(F.ws + WS_H);
    const float* lg = F.in[9] + (size_t)(l * 2 + sub) * D; const float* lb = F.in[10] + (size_t)(l * 2 + sub) * D;
    const int goff = sub == 0 ? 2 * D : 5 * D;
    const bool has_next = !(l == 3 && sub == 1);
    const int nl = sub == 0 ? l : l + 1, shoff = sub == 0 ? 3 * D : 0, scoff = sub == 0 ? 4 * D : D;
    for (int row = gw; row < MTOK; row += NGW) {
        const int cd = row_cond(row);
        const float* md = MOD + ((size_t)l * NCOND + cd) * NMOD;
        f32x4 v[4]; float s = 0.f;
#pragma unroll
        for (int j = 0; j < 4; ++j) {
            const int col = 4 * F.lane + 256 * j;
            f32x4 y = *(const f32x4*)(Y + (size_t)row * D + col);
            if (nsplit > 1) y += *(const f32x4*)(Y + (size_t)MTOK * D + (size_t)row * D + col);
            if (bias) y += *(const f32x4*)(bias + col);
            const f32x4 x = *(const f32x4*)(F.out + (size_t)row * D + col);
            const f32x4 g = *(const f32x4*)(md + goff + col);
            v[j] = x * ALPHA + g * y;
            s += (v[j][0] + v[j][1]) + (v[j][2] + v[j][3]);
        }
        const float mean = wave_sum(s) * (1.f / D); float s2 = 0.f;
#pragma unroll
        for (int j = 0; j < 4; ++j) { v[j] = v[j] - mean; s2 += (v[j][0] * v[j][0] + v[j][1] * v[j][1]) + (v[j][2] * v[j][2] + v[j][3] * v[j][3]); }
        const float rstd = 1.f / sqrtf(wave_sum(s2) * (1.f / D) + LN_EPS);
        const float* mdn = MOD + ((size_t)(has_next ? nl : 0) * NCOND + cd) * NMOD;
#pragma unroll
        for (int j = 0; j < 4; ++j) {
            const int col = 4 * F.lane + 256 * j;
            const f32x4 xn = v[j] * rstd * *(const f32x4*)(lg + col) + *(const f32x4*)(lb + col);
            *(f32x4*)(F.out + (size_t)row * D + col) = xn;
            if (has_next) {
                const f32x4 sh = *(const f32x4*)(mdn + shoff + col), sc = *(const f32x4*)(mdn + scoff + col);
                const f32x4 h = xn * (sc + 1.0f) + sh;
                u32x2 w; w.x = pk2(h[0], h[1]); w.y = pk2(h[2], h[3]);
                *(u32x2*)(H + (size_t)row * D + col) = w;
            }
        }
    }
}

DI void phase_s1(Frame& F) {
    LAS float* kf = (LAS float*)F.lds;
    LAS float* vf = kf + 64 * 65;
    LAS float* wv = vf + 64 * 128;
    LAS float* gl = wv + 128;
    LAS float* red = gl + 256;
    const bf16_t* QKVO = (const bf16_t*)(F.ws + WS_QKVO);
    const float* GATES = (const float*)(F.ws + WS_GATES);
    float* L = (float*)(F.ws + WS_L); float* NL = (float*)(F.ws + WS_NL); float* MLOC = (float*)(F.ws + WS_MLOC); float* BLAST = (float*)(F.ws + WS_BLAST);
    const int tid = F.tid;
    for (int item = F.bid; item < 1024; item += F.G) {
        const int gb = item >> 3, h = item & 7, row0 = gb * 64;
        __syncthreads();
        { const int j = tid >> 3, c8 = (tid & 7) * 8;
          const u32x4 kk = *(const u32x4*)(QKVO + (size_t)(row0 + j) * 3072 + 512 + h * 64 + c8);
#pragma unroll
          for (int e = 0; e < 4; ++e) { kf[j * 65 + c8 + 2 * e] = __uint_as_float(kk[e] << 16); kf[j * 65 + c8 + 2 * e + 1] = __uint_as_float(kk[e] & 0xffff0000u); }
          const int c16 = (tid & 7) * 16;
#pragma unroll
          for (int q = 0; q < 2; ++q) { const u32x4 vv = *(const u32x4*)(QKVO + (size_t)(row0 + j) * 3072 + 1024 + h * 128 + c16 + q * 8);
#pragma unroll
              for (int e = 0; e < 4; ++e) { vf[j * 128 + c16 + q * 8 + 2 * e] = __uint_as_float(vv[e] << 16); vf[j * 128 + c16 + q * 8 + 2 * e + 1] = __uint_as_float(vv[e] & 0xffff0000u); } }
          if (tid < 256) { const int d = tid >> 7, io = (tid >> 6) & 1, jj = tid & 63; gl[(io * 2 + d) * 64 + jj] = GATES[(size_t)(row0 + jj) * 32 + d * 16 + io * 8 + h]; } }
        __syncthreads();
        if (tid < 128) {
            const int d = tid >> 6, j = tid & 63; const LAS float* lf = gl + (2 + d) * 64;
            float e = 0.f, tot = 0.f;
            for (int u = 0; u < 64; ++u) { const float f = lf[u]; tot += f; if (d == 0 ? (u > j) : (u < j)) e += f; }
            const float a = e + gl[d * 64 + j];
            const float mloc = wave_max(a);
            wv[d * 64 + j] = expf(a - mloc);
            if (j == 0) { red[d] = mloc; red[2 + d] = tot; }
        }
        __syncthreads();
        const int dq = tid >> 3, vg = tid & 7;
        f32x4 a0[4], a1[4]; float n0 = 0.f, n1 = 0.f;
#pragma unroll
        for (int q = 0; q < 4; ++q) { a0[q] = (f32x4){0.f, 0.f, 0.f, 0.f}; a1[q] = (f32x4){0.f, 0.f, 0.f, 0.f}; }
        for (int j = 0; j < 64; ++j) {
            const float kk = kf[j * 65 + dq]; const float w0 = wv[j] * kk, w1 = wv[64 + j] * kk; n0 += w0; n1 += w1;
#pragma unroll
            for (int q = 0; q < 4; ++q) { const f32x4 vv = *(const LAS f32x4*)(vf + j * 128 + vg * 16 + q * 4); a0[q] += vv * w0; a1[q] += vv * w1; }
        }
        const size_t idx0 = (size_t)(gb * 8 + h) * 2;
#pragma unroll
        for (int q = 0; q < 4; ++q) { *(f32x4*)(L + idx0 * 8192 + dq * 128 + vg * 16 + q * 4) = a0[q]; *(f32x4*)(L + (idx0 + 1) * 8192 + dq * 128 + vg * 16 + q * 4) = a1[q]; }
        if (vg == 0) { NL[idx0 * 64 + dq] = n0; NL[(idx0 + 1) * 64 + dq] = n1; }
        if (tid < 2) { MLOC[idx0 + tid] = red[tid]; BLAST[idx0 + tid] = red[2 + tid]; }
    }
}

DI void phase_s2(Frame& F) {
    const float* L = (const float*)(F.ws + WS_L); const float* NL = (const float*)(F.ws + WS_NL);
    const float* MLOC = (const float*)(F.ws + WS_MLOC); const float* BLAST = (const float*)(F.ws + WS_BLAST);
    float* CINIT = (float*)(F.ws + WS_H1); float* NINIT = (float*)(F.ws + WS_NINIT); float* MINIT = (float*)(F.ws + WS_MINIT);
    const int tid = F.tid;
    for (int item = F.bid; item < 1280; item += F.G) {
        const int st = item >> 2, slab = item & 3, seq = st >> 4, h = (st >> 1) & 7, d = st & 1;
        const int e4 = (slab * 512 + tid) * 4;
        const int NC = seq < 16 ? 4 : 16, gb0 = seq < 16 ? seq * 4 : 64 + (seq - 16) * 16;
        const bool nthread = (slab == 0 && tid < 64);
        f32x4 C = (f32x4){0.f, 0.f, 0.f, 0.f}; float n = 0.f, m = 0.f;
        if (seq >= 16) { const size_t base = (size_t)((seq - 16) * 2 + d) * 8 + h; C = *(const f32x4*)(F.in[2] + base * 8192 + e4); if (nthread) n = F.in[3][base * 64 + tid]; m = F.in[4][base]; }
        for (int c = 0; c < NC; ++c) {
            const int gb = d == 0 ? gb0 + c : gb0 + NC - 1 - c; const size_t idx = (size_t)(gb * 8 + h) * 2 + d;
            *(f32x4*)(CINIT + idx * 8192 + e4) = C;
            if (nthread) NINIT[idx * 64 + tid] = n;
            if (slab == 0 && tid == 0) MINIT[idx] = m;
            const float bl = BLAST[idx], ml = MLOC[idx], mn = fmaxf(bl + m, ml), f1 = expf(bl + m - mn), f2 = expf(ml - mn);
            C = C * f1 + *(const f32x4*)(L + idx * 8192 + e4) * f2;
            if (nthread) n = n * f1 + NL[idx * 64 + tid] * f2;
            m = mn;
        }
        if (seq < 16) { const size_t ob = (size_t)(seq * 2 + d) * 8 + h; *(f32x4*)(F.out + OUT_NEWC + ob * 8192 + e4) = C; if (nthread) F.out[OUT_NEWN + ob * 64 + tid] = n; if (slab == 0 && tid == 0) F.out[OUT_NEWM + ob] = m; }
    }
}

DI void phase_s3(Frame& F) {
    LAS float* qf = (LAS float*)F.lds;
    LAS float* kf = qf + 64 * 65;
    LAS float* vf = kf + 64 * 65;
    LAS float* Cf = vf + 64 * 128;
    LAS float* Cb = Cf + 64 * 128;
    LAS float* gl = Cb + 64 * 128;
    LAS float* cum = gl + 256;
    LAS float* suf = cum + 64;
    LAS float* nfb = suf + 64;
    const bf16_t* QKVO = (const bf16_t*)(F.ws + WS_QKVO);
    const float* GATES = (const float*)(F.ws + WS_GATES);
    const float* CINIT = (const float*)(F.ws + WS_H1); const float* NINIT = (const float*)(F.ws + WS_NINIT); const float* MINIT = (const float*)(F.ws + WS_MINIT);
    bf16_t* HS = (bf16_t*)(F.ws + WS_HS);
    const float* norm_g = F.in[16];
    const int tid = F.tid;
    for (int item = F.bid; item < 1024; item += F.G) {
        const int gb = item >> 3, h = item & 7, row0 = gb * 64;
        const size_t idx0 = (size_t)(gb * 8 + h) * 2;
        __syncthreads();
        { const int j = tid >> 3, c8 = (tid & 7) * 8;
          const u32x4 qq = *(const u32x4*)(QKVO + (size_t)(row0 + j) * 3072 + h * 64 + c8);
          const u32x4 kk = *(const u32x4*)(QKVO + (size_t)(row0 + j) * 3072 + 512 + h * 64 + c8);
#pragma unroll
          for (int e = 0; e < 4; ++e) { qf[j * 65 + c8 + 2 * e] = __uint_as_float(qq[e] << 16); qf[j * 65 + c8 + 2 * e + 1] = __uint_as_float(qq[e] & 0xffff0000u);
                                        kf[j * 65 + c8 + 2 * e] = __uint_as_float(kk[e] << 16); kf[j * 65 + c8 + 2 * e + 1] = __uint_as_float(kk[e] & 0xffff0000u); }
          const int c16 = (tid & 7) * 16;
#pragma unroll
          for (int q = 0; q < 2; ++q) { const u32x4 vv = *(const u32x4*)(QKVO + (size_t)(row0 + j) * 3072 + 1024 + h * 128 + c16 + q * 8);
#pragma unroll
              for (int e = 0; e < 4; ++e) { vf[j * 128 + c16 + q * 8 + 2 * e] = __uint_as_float(vv[e] << 16); vf[j * 128 + c16 + q * 8 + 2 * e + 1] = __uint_as_float(vv[e] & 0xffff0000u); } }
          if (tid < 256) { const int d = tid >> 7, io = (tid >> 6) & 1, jj = tid & 63; gl[(io * 2 + d) * 64 + jj] = GATES[(size_t)(row0 + jj) * 32 + d * 16 + io * 8 + h]; }
          if (tid < 128) nfb[tid] = NINIT[(idx0 + (tid >> 6)) * 64 + (tid & 63)];
#pragma unroll
          for (int q = 0; q < 4; ++q) { const int e = tid * 4 + q * 2048; *(LAS f32x4*)(Cf + e) = *(const f32x4*)(CINIT + idx0 * 8192 + e); *(LAS f32x4*)(Cb + e) = *(const f32x4*)(CINIT + (idx0 + 1) * 8192 + e); } }
        const float mf = MINIT[idx0], mb = MINIT[idx0 + 1];
        __syncthreads();
        if (tid < 64) { float s = 0.f; for (int u = 0; u <= tid; ++u) s += gl[2 * 64 + u]; cum[tid] = s; }
        else if (tid < 128) { const int j = tid - 64; float s = 0.f; for (int u = j; u < 64; ++u) s += gl[3 * 64 + u]; suf[j] = s; }
        __syncthreads();
        const int t = tid >> 3, sub = tid & 7;
        float sr[8];
#pragma unroll
        for (int i = 0; i < 8; ++i) sr[i] = 0.f;
        float qnf = 0.f, qnb = 0.f;
        for (int dd = 0; dd < 64; ++dd) { const float qv = qf[t * 65 + dd];
#pragma unroll
            for (int i = 0; i < 8; ++i) sr[i] += qv * kf[(sub * 8 + i) * 65 + dd]; }
#pragma unroll
        for (int i = 0; i < 8; ++i) { const float qv = qf[t * 65 + sub * 8 + i]; qnf += qv * nfb[sub * 8 + i]; qnb += qv * nfb[64 + sub * 8 + i]; }
        qnf += __shfl_xor(qnf, 1); qnf += __shfl_xor(qnf, 2); qnf += __shfl_xor(qnf, 4);
        qnb += __shfl_xor(qnb, 1); qnb += __shfl_xor(qnb, 2); qnb += __shfl_xor(qnb, 4);
        const float ct = cum[t], stt = suf[t];
        float df[8], db[8]; float mxf = ct + mf, mxb = stt + mb;
#pragma unroll
        for (int i = 0; i < 8; ++i) { const int s = sub * 8 + i;
            df[i] = (s <= t) ? (ct - cum[s] + gl[s]) : -INFINITY; db[i] = (s >= t) ? (stt - suf[s] + gl[64 + s]) : -INFINITY;
            mxf = fmaxf(mxf, df[i]); mxb = fmaxf(mxb, db[i]); }
        mxf = fmaxf(mxf, __shfl_xor(mxf, 1)); mxf = fmaxf(mxf, __shfl_xor(mxf, 2)); mxf = fmaxf(mxf, __shfl_xor(mxf, 4));
        mxb = fmaxf(mxb, __shfl_xor(mxb, 1)); mxb = fmaxf(mxb, __shfl_xor(mxb, 2)); mxb = fmaxf(mxb, __shfl_xor(mxb, 4));
        float pf[8], pb[8], sumf = 0.f, sumb = 0.f;
#pragma unroll
        for (int i = 0; i < 8; ++i) { const int s = sub * 8 + i;
            pf[i] = (s <= t) ? sr[i] * expf(df[i] - mxf) : 0.f; pb[i] = (s >= t) ? sr[i] * expf(db[i] - mxb) : 0.f; sumf += pf[i]; sumb += pb[i]; }
        sumf += __shfl_xor(sumf, 1); sumf += __shfl_xor(sumf, 2); sumf += __shfl_xor(sumf, 4);
        sumb += __shfl_xor(sumb, 1); sumb += __shfl_xor(sumb, 2); sumb += __shfl_xor(sumb, 4);
        const float af = expf(ct + mf - mxf), ab = expf(stt + mb - mxb);
        const float rf = 1.0f / fmaxf(fabsf(sumf + af * qnf), expf(-mxf)), rb = 1.0f / fmaxf(fabsf(sumb + ab * qnb), expf(-mxb));
        const float cf = af * rf, cb = ab * rb;
        __syncthreads();
        LAS float* Pm = kf;
#pragma unroll
        for (int i = 0; i < 8; ++i) Pm[t * 65 + sub * 8 + i] = pf[i] * rf + pb[i] * rb;
        __syncthreads();
        const int vg = sub;
        f32x4 acc[4];
#pragma unroll
        for (int q = 0; q < 4; ++q) acc[q] = (f32x4){0.f, 0.f, 0.f, 0.f};
        for (int s = 0; s < 64; ++s) { const float p = Pm[t * 65 + s];
#pragma unroll
            for (int q = 0; q < 4; ++q) acc[q] += *(const LAS f32x4*)(vf + s * 128 + vg * 16 + q * 4) * p; }
        for (int dd = 0; dd < 64; ++dd) { const float qv = qf[t * 65 + dd]; const float a = qv * cf, b = qv * cb;
#pragma unroll
            for (int q = 0; q < 4; ++q) acc[q] += *(const LAS f32x4*)(Cf + dd * 128 + vg * 16 + q * 4) * a + *(const LAS f32x4*)(Cb + dd * 128 + vg * 16 + q * 4) * b; }
        float sm = 0.f;
#pragma unroll
        for (int q = 0; q < 4; ++q) sm += (acc[q][0] + acc[q][1]) + (acc[q][2] + acc[q][3]);
        sm += __shfl_xor(sm, 1); sm += __shfl_xor(sm, 2); sm += __shfl_xor(sm, 4);
        const float mu = sm * (1.0f / 128.0f); float vs = 0.f;
#pragma unroll
        for (int q = 0; q < 4; ++q) { acc[q] = acc[q] - mu; vs += (acc[q][0] * acc[q][0] + acc[q][1] * acc[q][1]) + (acc[q][2] * acc[q][2] + acc[q][3] * acc[q][3]); }
        vs += __shfl_xor(vs, 1); vs += __shfl_xor(vs, 2); vs += __shfl_xor(vs, 4);
        const float rstd = 1.0f / sqrtf(vs * (1.0f / 128.0f) + LN_EPS);
        const size_t orow = (size_t)(row0 + t);
#pragma unroll
        for (int q2 = 0; q2 < 2; ++q2) {
            const u32x4 ov = *(const u32x4*)(QKVO + orow * 3072 + 2048 + h * 128 + vg * 16 + q2 * 8);
            u32x4 w;
#pragma unroll
            for (int e = 0; e < 4; ++e) {
                const int q = q2 * 2 + (e >> 1), i0 = (e & 1) * 2;
                const float g0 = norm_g[h * 128 + vg * 16 + q * 4 + i0], g1 = norm_g[h * 128 + vg * 16 + q * 4 + i0 + 1];
                const float o0 = __uint_as_float(ov[e] << 16), o1 = __uint_as_float(ov[e] & 0xffff0000u);
                w[e] = pk2(acc[q][i0] * rstd * g0 * sigmoidf_(o0), acc[q][i0 + 1] * rstd * g1 * sigmoidf_(o1));
            }
            *(u32x4*)(HS + orow * D + h * 128 + vg * 16 + q2 * 8) = w;
        }
    }
}

DI void phase_conv(Frame& F) {
    const bf16_t* BCU = (const bf16_t*)(F.ws + WS_QKVO); bf16_t* HS = (bf16_t*)(F.ws + WS_HS);
    const float* cw = F.in[19];
    const int gt = F.bid * NTHR + F.tid, NGT = F.G * NTHR;
    for (int i = gt; i < MTOK * 128; i += NGT) {
        const int row = i >> 7, c8 = (i & 127) * 8;
        const int s = row < NCTX ? (row & 255) : ((row - NCTX) & 1023), S = row < NCTX ? 256 : 1024;
        float accv[8];
#pragma unroll
        for (int e = 0; e < 8; ++e) accv[e] = 0.f;
#pragma unroll
        for (int j = 0; j < 3; ++j) {
            const int ss = s + j - 1;
            if (ss >= 0 && ss < S) {
                const size_t r2 = (size_t)(row + j - 1);
                const u32x4 cg = *(const u32x4*)(BCU + r2 * 3072 + 1024 + c8), uu = *(const u32x4*)(BCU + r2 * 3072 + 2048 + c8);
#pragma unroll
                for (int e = 0; e < 4; ++e) {
                    const float w0 = cw[j * D + c8 + 2 * e], w1 = cw[j * D + c8 + 2 * e + 1];
                    accv[2 * e] += w0 * (__uint_as_float(cg[e] << 16) * __uint_as_float(uu[e] << 16));
                    accv[2 * e + 1] += w1 * (__uint_as_float(cg[e] & 0xffff0000u) * __uint_as_float(uu[e] & 0xffff0000u));
                }
            }
        }
        const u32x4 bg = *(const u32x4*)(BCU + (size_t)row * 3072 + c8);
        u32x4 w;
#pragma unroll
        for (int e = 0; e < 4; ++e) w[e] = pk2(__uint_as_float(bg[e] << 16) * accv[2 * e], __uint_as_float(bg[e] & 0xffff0000u) * accv[2 * e + 1]);
        *(u32x4*)(HS + (size_t)row * D + c8) = w;
    }
}

DI void phase_poolprep(Frame& F) {
    const float* MOD = (const float*)(F.ws + WS_MOD); bf16_t* HS = (bf16_t*)(F.ws + WS_HS);
    const int gt = F.bid * NTHR + F.tid, NGT = F.G * NTHR;
    for (int i = gt; i < MTOK * 256; i += NGT) {
        const int row = i >> 8, c4 = (i & 255) * 4;
        const int cd = row_cond(row);
        const int s = row < NCTX ? (row & 255) : ((row - NCTX) & 1023), S = row < NCTX ? 256 : 1024;
        const float* md = MOD + ((size_t)2 * NCOND + cd) * NMOD;
        const f32x4 sh = *(const f32x4*)(md + c4), sc = *(const f32x4*)(md + D + c4) + 1.0f;
        const int win = 2 << (c4 >> 8);
        int lo = s - win / 2; if (lo < 0) lo = 0; int hi = s + win - win / 2; if (hi > S) hi = S;
        f32x4 sum = (f32x4){0.f, 0.f, 0.f, 0.f};
        for (int u = lo; u < hi; ++u) sum += *(const f32x4*)(F.out + (size_t)(row + u - s) * D + c4) * sc + sh;
        const f32x4 hh = *(const f32x4*)(F.out + (size_t)row * D + c4) * sc + sh;
        const f32x4 p = sum * (1.0f / (float)(hi - lo)) - hh;
        u32x2 w; w.x = pk2(p[0], p[1]); w.y = pk2(p[2], p[3]);
        *(u32x2*)(HS + (size_t)row * D + c4) = w;
    }
}

constexpr int NPHASE = 31;
enum { PK_PRO_A = 0, PK_PRO_B, PK_LN0, PK_UP, PK_DOWN, PK_LN1, PK_ML_IN, PK_S1, PK_S2, PK_S3, PK_OUTPROJ, PK_SC_IN, PK_CONV, PK_POOLPREP, PK_POOLGEMM, PK_F1, PK_F2, PK_COUNT };
template <int SKIND> DI Sched<SKIND> make_sched(Frame& F, const bf16_t* A, int lda, const bf16_t* Bt, int ldb, int n_units, int nN, int nt, int rot) {
    Sched<SKIND> S; S.G = F.G; S.c = (F.bid + rot) % F.G; S.n_units = n_units; S.nN = nN; S.nt = nt; S.A = A; S.Bt = Bt; S.lda = lda; S.ldb = ldb; return S;
}
template <int EKIND> DI Epi<EKIND> make_epi(bf16_t* ob, float* of, int ldc, const float* p0, const float* p1) { Epi<EKIND> E; E.ob = ob; E.of = of; E.ldc = ldc; E.p0 = p0; E.p1 = p1; return E; }

template <int PK> DI void run_kind(Frame& F, int layer) {
    unsigned char* ws = F.ws;
    const bf16_t* H = (const bf16_t*)(ws + WS_H); const bf16_t* HS = (const bf16_t*)(ws + WS_HS);
    if constexpr (PK == PK_PRO_A) phase_prologue_a(F);
    else if constexpr (PK == PK_PRO_B) phase_prologue_b(F);
    else if constexpr (PK == PK_LN0) phase_ln(F, layer, 0, layer == 2 ? 1 : 2, layer == 3 ? F.in[25] : nullptr);
    else if constexpr (PK == PK_LN1) phase_ln(F, layer, 1, 2, nullptr);
    else if constexpr (PK == PK_UP) { auto S = make_sched<K_STD>(F, H, D, (const bf16_t*)(ws + WS_WT_W1) + (size_t)layer * D * FF, D, 512, 16, 16, 0);
        auto E = make_epi<E_RELU2>((bf16_t*)(ws + WS_H1), nullptr, FF, nullptr, nullptr); gemm_run(F, S, E); }
    else if constexpr (PK == PK_DOWN) { auto S = make_sched<K_SPLIT2>(F, (const bf16_t*)(ws + WS_H1), FF, (const bf16_t*)(ws + WS_WT_W2) + (size_t)layer * D * FF, FF, 256, 4, 32, 0);
        auto E = make_epi<E_F32SPLIT>(nullptr, (float*)(ws + WS_Y), 0, nullptr, nullptr); gemm_run(F, S, E); }
    else if constexpr (PK == PK_ML_IN) { auto S = make_sched<K_STD>(F, H, D, (const bf16_t*)(ws + WS_WT_MLIN), D, 32 * 13, 13, 16, 0);
        auto E = make_epi<E_ML>((bf16_t*)(ws + WS_QKVO), (float*)(ws + WS_GATES), 0, F.in[15], nullptr); gemm_run(F, S, E); }
    else if constexpr (PK == PK_S1) phase_s1(F);
    else if constexpr (PK == PK_S2) phase_s2(F);
    else if constexpr (PK == PK_S3) phase_s3(F);
    else if constexpr (PK == PK_OUTPROJ) { const size_t wo = layer == 0 ? WS_WT_MLOUT : (layer == 1 ? WS_WT_SCOUT : WS_WT_FT);
        auto S = make_sched<K_SPLIT2>(F, HS, D, (const bf16_t*)(ws + wo), D, 256, 4, 8, 0);
        auto E = make_epi<E_F32SPLIT>(nullptr, (float*)(ws + WS_Y), 0, nullptr, nullptr); gemm_run(F, S, E); }
    else if constexpr (PK == PK_SC_IN) { auto S = make_sched<K_STD>(F, H, D, (const bf16_t*)(ws + WS_WT_SCIN), D, 32 * 12, 12, 16, 0);
        auto E = make_epi<E_BF16>((bf16_t*)(ws + WS_QKVO), nullptr, 3072, nullptr, nullptr); gemm_run(F, S, E); }
    else if constexpr (PK == PK_CONV) phase_conv(F);
    else if constexpr (PK == PK_POOLPREP) phase_poolprep(F);
    else if constexpr (PK == PK_POOLGEMM) { auto S = make_sched<K_POOL>(F, HS, D, (const bf16_t*)(ws + WS_WT_PL), 256, 128, 4, 4, 0);
        auto E = make_epi<E_POOL>(nullptr, (float*)(ws + WS_Y), 0, F.in[22], F.in[23]); gemm_run(F, S, E); }
    else if constexpr (PK == PK_F1) { auto S = make_sched<K_F1>(F, (const bf16_t*)(ws + WS_WC), 256, H, D, 256, 32, 4, 0);
        auto E = make_epi<E_F1>((bf16_t*)(ws + WS_QKVO), nullptr, 0, nullptr, nullptr); gemm_run(F, S, E); }
    else { auto E = make_epi<E_F2>((bf16_t*)(ws + WS_HS), nullptr, 0, nullptr, nullptr);
        { auto S = make_sched<K_F2L>(F, (const bf16_t*)(ws + WS_T1024), 2048, (const bf16_t*)(ws + WS_QKVO) + (size_t)16 * 1024 * 512, 2048, 64, 4, 32, 0); gemm_run(F, S, E); }
        __syncthreads();
        { auto S = make_sched<K_F2C>(F, (const bf16_t*)(ws + WS_T256), 512, (const bf16_t*)(ws + WS_QKVO), 512, 64, 4, 8, (F.G > 64 ? F.G - 64 : 0)); gemm_run(F, S, E); } }
}

__host__ __device__ inline void phase_of(int ph, int& pk, int& layer) {
    layer = 0;
    if (ph >= 7 && ph <= 10) { layer = 0; pk = PK_LN0 + (ph - 7); return; }
    if (ph >= 14 && ph <= 17) { layer = 1; pk = PK_LN0 + (ph - 14); return; }
    if (ph >= 20 && ph <= 23) { layer = 2; pk = PK_LN0 + (ph - 20); return; }
    if (ph >= 27 && ph <= 30) { layer = 3; pk = PK_LN0 + (ph - 27); return; }
    switch (ph) {
    case 0: pk = PK_PRO_A; break; case 1: pk = PK_PRO_B; break; case 2: pk = PK_ML_IN; break; case 3: pk = PK_S1; break; case 4: pk = PK_S2; break; case 5: pk = PK_S3; break;
    case 6: layer = 0; pk = PK_OUTPROJ; break; case 11: pk = PK_SC_IN; break; case 12: pk = PK_CONV; break; case 13: layer = 1; pk = PK_OUTPROJ; break;
    case 18: pk = PK_POOLPREP; break; case 19: pk = PK_POOLGEMM; break; case 24: pk = PK_F1; break; case 25: pk = PK_F2; break; default: layer = 3; pk = PK_OUTPROJ; break;
    }
}

DI void frame_init(Frame& F, const Args& args, unsigned char* lds_raw) {
    F.lds = (LAS unsigned char*)lds_raw;
    F.tid = threadIdx.x; F.lane = F.tid & 63; F.wave = __builtin_amdgcn_readfirstlane(F.tid >> 6);
    F.G = gridDim.x; F.bid = blockIdx.x;
    F.in = (const float* const*)__builtin_amdgcn_kernarg_segment_ptr();
    F.out = args.out; F.ws = args.ws;
}

template <int PK> __global__ void __launch_bounds__(NTHR, 2) phase_kernel(Args args) {
    extern __shared__ __attribute__((aligned(16))) unsigned char lds_raw[];
    Frame F; frame_init(F, args, lds_raw);
    run_kind<PK>(F, args.ph_lo);
}

template <int PK> static void launch_phase(int grid, const Args& a, hipStream_t stream, bool setattr) {
    if (setattr) { (void)hipFuncSetAttribute((const void*)phase_kernel<PK>, hipFuncAttributeMaxDynamicSharedMemorySize, LDS_BYTES); return; }
    hipLaunchKernelGGL(phase_kernel<PK>, dim3(grid), dim3(NTHR), LDS_BYTES, stream, a);
}
static void launch_kind(int pk, int grid, const Args& a, hipStream_t stream, bool setattr) {
    switch (pk) {
    case PK_PRO_A: launch_phase<PK_PRO_A>(grid, a, stream, setattr); break;
    case PK_PRO_B: launch_phase<PK_PRO_B>(grid, a, stream, setattr); break;
    case PK_LN0: launch_phase<PK_LN0>(grid, a, stream, setattr); break;
    case PK_UP: launch_phase<PK_UP>(grid, a, stream, setattr); break;
    case PK_DOWN: launch_phase<PK_DOWN>(grid, a, stream, setattr); break;
    case PK_LN1: launch_phase<PK_LN1>(grid, a, stream, setattr); break;
    case PK_ML_IN: launch_phase<PK_ML_IN>(grid, a, stream, setattr); break;
    case PK_S1: launch_phase<PK_S1>(grid, a, stream, setattr); break;
    case PK_S2: launch_phase<PK_S2>(grid, a, stream, setattr); break;
    case PK_S3: launch_phase<PK_S3>(grid, a, stream, setattr); break;
    case PK_OUTPROJ: launch_phase<PK_OUTPROJ>(grid, a, stream, setattr); break;
    case PK_SC_IN: launch_phase<PK_SC_IN>(grid, a, stream, setattr); break;
    case PK_CONV: launch_phase<PK_CONV>(grid, a, stream, setattr); break;
    case PK_POOLPREP: launch_phase<PK_POOLPREP>(grid, a, stream, setattr); break;
    case PK_POOLGEMM: launch_phase<PK_POOLGEMM>(grid, a, stream, setattr); break;
    case PK_F1: launch_phase<PK_F1>(grid, a, stream, setattr); break;
    default: launch_phase<PK_F2>(grid, a, stream, setattr); break;
    }
}

extern "C" void kernel_launch(void* const* d_in, const int* in_sizes, int n_in, void* d_out, int out_size, void* d_ws, size_t ws_size, hipStream_t stream) {
    static int grid = 0;
    Args a{};
    if (grid == 0) {
        if (n_in != 26 || out_size != 10502400 || ws_size < WS_END) { fprintf(stderr, "kernel_launch: unexpected shapes (n_in %d out %d ws %zu)\n", n_in, out_size, ws_size); grid = -1; return; }
        int dev = 0, cus = 0;
        if (hipGetDevice(&dev) != hipSuccess || hipDeviceGetAttribute(&cus, hipDeviceAttributeMultiprocessorCount, dev) != hipSuccess) { grid = -1; return; }
        for (int pk = 0; pk < PK_COUNT; ++pk) launch_kind(pk, 0, a, stream, true);
        (void)hipGetLastError();
        grid = cus;
    }
    if (grid < 0) return;
    for (int i = 0; i < 26; ++i) a.in[i] = (const float*)d_in[i];
    a.out = (float*)d_out; a.ws = (unsigned char*)d_ws;
    for (int ph = 0; ph < NPHASE; ++ph) {
        int pk, layer; phase_of(ph, pk, layer);
        a.ph_lo = layer; a.ph_hi = 0;
        launch_kind(pk, grid, a, stream, false);
    }
}
```

```cpp
#include <hip/hip_runtime.h>
#include <cstdio>
#include <cstdint>

#ifndef MK_ONE_LAUNCH
#define MK_ONE_LAUNCH 1
#endif

#define LAS __attribute__((address_space(3)))
#define GAS __attribute__((address_space(1)))
typedef unsigned short bf16_t;
typedef short bf16x8 __attribute__((ext_vector_type(8)));
typedef float f32x4 __attribute__((ext_vector_type(4)));
typedef float f32x2 __attribute__((ext_vector_type(2)));
typedef unsigned u32x4 __attribute__((ext_vector_type(4)));
typedef unsigned u32x2 __attribute__((ext_vector_type(2)));
#define DI __device__ __forceinline__

constexpr int D = 1024, MTOK = 8192, NCTX = 4096, FF = 4096, NHEAD = 8, DQK = 64, DHV = 128;
constexpr int MLN = 3328;
constexpr int NCOND = 5, NMOD = 6 * D;
constexpr float ALPHA = 1.6817928305074292f;
constexpr float LN_EPS = 1e-5f;
constexpr int NWAVES = 8, NTHR = 512;
constexpr int LDS_BYTES = 147456;

constexpr size_t MiB = 1u << 20;
constexpr size_t WS_CTL = 0, CTL_ZERO_BYTES = 64 * 1024;
constexpr size_t WS_MOD = 1 * MiB;
constexpr size_t WS_WT_MLIN = 2 * MiB;
constexpr size_t WS_WT_MLOUT = 9 * MiB;
constexpr size_t WS_WT_SCIN = 11 * MiB;
constexpr size_t WS_WT_SCOUT = 17 * MiB;
constexpr size_t WS_WT_PL = 19 * MiB;
constexpr size_t WS_WT_FT = 20 * MiB;
constexpr size_t WS_WC = 22 * MiB;
constexpr size_t WS_T256 = 22 * MiB + 256 * 1024;
constexpr size_t WS_T1024 = 22 * MiB + 512 * 1024;
constexpr size_t WS_WT_W1 = 27 * MiB;
constexpr size_t WS_WT_W2 = 59 * MiB;
constexpr size_t WS_H = 91 * MiB;
constexpr size_t WS_HS = 107 * MiB;
constexpr size_t WS_Y = 123 * MiB;
constexpr size_t WS_QKVO = 187 * MiB;
constexpr size_t WS_H1 = 235 * MiB;
constexpr size_t WS_GATES = 299 * MiB;
constexpr size_t WS_L = 300 * MiB;
constexpr size_t WS_NL = 364 * MiB;
constexpr size_t WS_NINIT = 364 * MiB + 512 * 1024;
constexpr size_t WS_MLOC = 365 * MiB;
constexpr size_t WS_BLAST = 365 * MiB + 8192;
constexpr size_t WS_MINIT = 365 * MiB + 16384;
constexpr size_t WS_END = 366 * MiB;

constexpr size_t OUT_YS = 0, OUT_NEWC = 8388608, OUT_NEWN = 10485760, OUT_NEWM = 10502144;

DI float bf2f(unsigned short b) { return __uint_as_float((unsigned)b << 16); }
DI unsigned f2bf(float f) { unsigned u = __float_as_uint(f); return (u + 0x7fffu + ((u >> 16) & 1u)) >> 16; }
DI unsigned pk2(float lo, float hi) { return f2bf(lo) | (f2bf(hi) << 16); }
DI float sigmoidf_(float x) { return 1.0f / (1.0f + __expf(-x)); }

namespace pg8 {
constexpr int BM = 256, BK = 64, HALF = 128, HTB = HALF * BK * 2, STAGE_BYTES = 8 * HTB;
__host__ __device__ __forceinline__ int lds_byte(int r, int c) { const int st = (r >> 4) * 2 + (c >> 5), rr = r & 15, cc = c & 31, ob = rr * 64 + cc * 2; return st * 1024 + (ob ^ (((ob >> 9) & 1) << 5)); }
__host__ __device__ __forceinline__ void stage_rc(int b, int& R, int& C) { const int st = b / 1024, sb = b % 1024, swz = sb ^ (((sb >> 9) & 1) << 5); R = (st >> 1) * 16 + swz / 64; C = (st & 1) * 32 + (swz % 64) / 2; }

struct Unit { const char* a; const char* b; int nt, pm, pn, aux; };

template <class Epi, class Sched>
DI void gemm_phase(LAS unsigned char* lds, const int tid, const int lda, const int ldb, const Sched& S, const Epi& E) {
    const int wid = __builtin_amdgcn_readfirstlane(tid >> 6), lane = tid & 63, wr = wid >> 2, wc = wid & 3, fr = lane & 15, fq = lane >> 4;
    unsigned voffA[2], voffB[2];
#pragma unroll
    for (int i = 0; i < 2; ++i) { int R, C; stage_rc(tid * 16 + i * 8192, R, C); voffA[i] = (unsigned)(R * lda + C) * 2u; voffB[i] = (unsigned)(R * ldb + C) * 2u; }
    const size_t kstep = (size_t)(BK * 2);
    const size_t hstepA = (size_t)HALF * lda * 2, hstepB = (size_t)HALF * ldb * 2;
    const unsigned ldsw = (unsigned)wid * 1024u;
    const int aoff = lds_byte(wr * 64 + fr, fq * 8), boff = lds_byte(wc * 32 + fr, fq * 8);
#define PG8_SA(b, h) (((b) * 2 + (h)) * HTB)
#define PG8_SB(b, h) ((4 + (b) * 2 + (h)) * HTB)
#define PG8_STAGE(bufoff, gbase, voff) do { _Pragma("unroll") for (int _i = 0; _i < 2; ++_i) \
        __builtin_amdgcn_global_load_lds((const unsigned*)((const char*)(gbase) + (voff)[_i]), (LAS unsigned*)(lds + (bufoff) + ldsw + _i * 8192), 16, 0, 0); } while (0)
#define PG8_LDA(dst, b, h) do { _Pragma("unroll") for (int m = 0; m < 4; ++m) _Pragma("unroll") for (int k = 0; k < 2; ++k) dst[m][k] = *(const LAS bf16x8*)(lds + PG8_SA(b, h) + aoff + m * 2048 + k * 1024); } while (0)
#define PG8_LDB(dst, b, h) do { _Pragma("unroll") for (int n = 0; n < 2; ++n) _Pragma("unroll") for (int k = 0; k < 2; ++k) dst[n][k] = *(const LAS bf16x8*)(lds + PG8_SB(b, h) + boff + n * 2048 + k * 1024); } while (0)
#define PG8_MMA(ai, bj, At, Bt) do { __builtin_amdgcn_s_setprio(1); _Pragma("unroll") for (int m = 0; m < 4; ++m) _Pragma("unroll") for (int n = 0; n < 2; ++n) _Pragma("unroll") for (int k = 0; k < 2; ++k) \
        acc[ai][bj][m][n] = __builtin_amdgcn_mfma_f32_16x16x32_bf16(Bt[n][k], At[m][k], acc[ai][bj][m][n], 0, 0, 0); __builtin_amdgcn_s_setprio(0); } while (0)
#define PG8_WAIT_V(n) asm volatile("s_waitcnt vmcnt(" #n ")" ::: "memory")
#define PG8_WAIT_L(n) asm volatile("s_waitcnt lgkmcnt(" #n ")" ::: "memory")
#define PG8_BAR __builtin_amdgcn_s_barrier()
#define PG8_SCHED __builtin_amdgcn_sched_barrier(0)
    Unit cur, nxt; int ui = 0;
    if (!S.next(0, cur)) return;
    f32x4 acc[2][2][4][2];
#pragma unroll
    for (int a = 0; a < 2; ++a)
#pragma unroll
        for (int b = 0; b < 2; ++b)
#pragma unroll
            for (int m = 0; m < 4; ++m)
#pragma unroll
                for (int n = 0; n < 2; ++n) acc[a][b][m][n] = (f32x4){0.f, 0.f, 0.f, 0.f};
    bf16x8 At[4][2], B0[2][2], B1[2][2];
    const char* cA = cur.a; const char* cB = cur.b;
    PG8_STAGE(PG8_SB(0, 0), cB, voffB); PG8_STAGE(PG8_SB(0, 1), cB + hstepB, voffB); PG8_STAGE(PG8_SA(0, 0), cA, voffA); PG8_STAGE(PG8_SA(0, 1), cA + hstepA, voffA);
    if (wr == 1) PG8_BAR;
    PG8_WAIT_V(2); PG8_BAR;
    PG8_STAGE(PG8_SB(1, 0), cB + kstep, voffB); PG8_STAGE(PG8_SA(1, 0), cA + kstep, voffA); PG8_STAGE(PG8_SB(1, 1), cB + hstepB + kstep, voffB);
    PG8_WAIT_V(6); PG8_BAR;
    for (;;) {
        const bool has_next = S.next(ui + 1, nxt);
        const char* nA = has_next ? nxt.a : cA; const char* nB = has_next ? nxt.b : cB;
        const int nt = cur.nt;
        for (int t = 0; t < nt; t += 2) {
            const bool last = (t == nt - 2);
            const char* a1 = cA + (size_t)(t + 1) * kstep;
            const char* a2 = last ? nA : cA + (size_t)(t + 2) * kstep; const char* b2 = last ? nB : cB + (size_t)(t + 2) * kstep;
            const char* a3 = a2 + kstep; const char* b3 = b2 + kstep;
            PG8_LDB(B0, 0, 0); PG8_LDB(B1, 0, 1); PG8_SCHED; PG8_LDA(At, 0, 0); PG8_STAGE(PG8_SA(1, 1), a1 + hstepA, voffA);
            PG8_WAIT_V(8); PG8_WAIT_L(0); PG8_BAR; PG8_MMA(0, 0, At, B0); PG8_MMA(0, 1, At, B1); PG8_BAR; PG8_SCHED;
            PG8_LDA(At, 0, 1); PG8_STAGE(PG8_SB(0, 0), b2, voffB); PG8_STAGE(PG8_SB(0, 1), b2 + hstepB, voffB); PG8_STAGE(PG8_SA(0, 0), a2, voffA);
            PG8_WAIT_V(8); PG8_WAIT_L(0); PG8_BAR; PG8_MMA(1, 0, At, B0); PG8_MMA(1, 1, At, B1); PG8_BAR; PG8_SCHED;
            PG8_LDB(B0, 1, 0); PG8_LDB(B1, 1, 1); PG8_SCHED; PG8_LDA(At, 1, 0); PG8_STAGE(PG8_SA(0, 1), a2 + hstepA, voffA);
            PG8_WAIT_V(8); PG8_WAIT_L(0); PG8_BAR; PG8_MMA(0, 0, At, B0); PG8_MMA(0, 1, At, B1); PG8_BAR; PG8_SCHED;
            PG8_LDA(At, 1, 1); PG8_STAGE(PG8_SB(1, 0), b3, voffB); PG8_STAGE(PG8_SB(1, 1), b3 + hstepB, voffB); PG8_STAGE(PG8_SA(1, 0), a3, voffA);
            PG8_WAIT_V(8); PG8_WAIT_L(0); PG8_BAR; PG8_MMA(1, 0, At, B0); PG8_MMA(1, 1, At, B1); PG8_BAR; PG8_SCHED;
        }
        if (wr == 0) PG8_BAR;
        E(acc, cur, wr, wc, fr, fq);
        if (!has_next) break;
#pragma unroll
        for (int a = 0; a < 2; ++a)
#pragma unroll
            for (int b = 0; b < 2; ++b)
#pragma unroll
                for (int m = 0; m < 4; ++m)
#pragma unroll
                    for (int n = 0; n < 2; ++n) acc[a][b][m][n] = (f32x4){0.f, 0.f, 0.f, 0.f};
        cur = nxt; cA = nA; cB = nB; ++ui;
        if (wr == 1) PG8_BAR;
    }
    PG8_WAIT_V(0);
    PG8_BAR;
#undef PG8_SA
#undef PG8_SB
#undef PG8_STAGE
#undef PG8_LDA
#undef PG8_LDB
#undef PG8_MMA
#undef PG8_WAIT_V
#undef PG8_WAIT_L
#undef PG8_BAR
#undef PG8_SCHED
}
}

typedef GAS unsigned gu32;
#define RLX_AGENT __ATOMIC_RELAXED, __HIP_MEMORY_SCOPE_AGENT
#define XB_TMO      128
#define XB_XCNT(j)  (256  + 64 * (j))
#define XB_XSUB(j)  (1280 + 64 * (j))
#define XB_XGEN(j)  (2304 + 64 * (j))
#define XB_TOP      3328
#define XB_TOPGEN   3392
#define XCD_BAR_WORDS 3456
#define XB_SPIN_CAP (1u << 20)
DI unsigned xb_ld(unsigned* p)              { return __hip_atomic_load(p, __ATOMIC_RELAXED, __HIP_MEMORY_SCOPE_AGENT); }
DI unsigned xb_add(unsigned* p, unsigned v) { return __hip_atomic_fetch_add(p, v, __ATOMIC_RELAXED, __HIP_MEMORY_SCOPE_AGENT); }
DI unsigned xb_xcc_id() { return (unsigned)__builtin_amdgcn_s_getreg((3 << 11) | 20) & 0xFu; }
#define XB_SPIN(cond, bar) do { unsigned _sp = 0; while (cond) { __builtin_amdgcn_s_sleep(1); \
    if ((++_sp & 255u) == 0u) { if (xb_ld(&(bar)[XB_TMO])) break; if (_sp > XB_SPIN_CAP) { atomicAdd(&(bar)[XB_TMO], 1u); break; } } } } while (0)
struct XcdBarrier { unsigned* bar; unsigned x; volatile LAS unsigned* st; };
DI XcdBarrier xcd_barrier_post(unsigned* bar, volatile LAS unsigned* st) {
    XcdBarrier b; b.bar = bar; b.x = xb_xcc_id(); b.st = st;
    if (threadIdx.x == 0) (void)xb_add(&bar[XB_XCNT(b.x)], 1u);
    return b;
}
DI void xcd_barrier_complete(unsigned* bar, unsigned x, unsigned& nloc, unsigned& nx) {
    const unsigned G = gridDim.x * gridDim.y * gridDim.z;
    unsigned sum, cnt, mine, sp = 0u;
    for (;;) {
        sum = 0u; cnt = 0u; mine = 0u;
#pragma unroll
        for (unsigned j = 0; j < 16; ++j) { const unsigned c = xb_ld(&bar[XB_XCNT(j)]); sum += c; cnt += (c > 0u) ? 1u : 0u; mine = (j == x) ? c : mine; }
        if (sum == G) break;
        __builtin_amdgcn_s_sleep(1);
        if ((++sp & 255u) == 0u) { if (xb_ld(&bar[XB_TMO])) break; if (sp > XB_SPIN_CAP) { atomicAdd(&bar[XB_TMO], 1u); break; } }
    }
    nloc = mine > 0u ? mine : 1u; nx = cnt > 0u ? cnt : 1u;
}
DI void xcd_barrier(const XcdBarrier& b) {
    asm volatile("s_waitcnt vmcnt(0)" ::: "memory");
    __syncthreads();
    if (threadIdx.x == 0) {
        unsigned* bar = b.bar;
        __builtin_amdgcn_s_waitcnt(0);
        unsigned nloc = b.st[0], nx = b.st[1];
        if (nloc == 0u) { xcd_barrier_complete(bar, b.x, nloc, nx); b.st[0] = nloc; b.st[1] = nx; }
        const unsigned old = xb_add(&bar[XB_XSUB(b.x)], 1u);
        const unsigned gen = old / nloc;
        if (old + 1u == (gen + 1u) * nloc) {
            __builtin_amdgcn_fence(__ATOMIC_RELEASE, "agent");
            asm volatile("s_waitcnt vmcnt(0)" ::: "memory");
            const unsigned og = xb_add(&bar[XB_TOP], 1u);
            const unsigned tg = og / nx;
            if (og + 1u == (tg + 1u) * nx) xb_add(&bar[XB_TOPGEN], 1u);
            else XB_SPIN(xb_ld(&bar[XB_TOPGEN]) == tg, bar);
            __builtin_amdgcn_fence(__ATOMIC_ACQUIRE, "agent");
            xb_add(&bar[XB_XGEN(b.x)], 1u);
            asm volatile("s_waitcnt vmcnt(0)" ::: "memory");
        } else {
            XB_SPIN(xb_ld(&bar[XB_XGEN(b.x)]) == gen, bar);
            __builtin_amdgcn_fence(__ATOMIC_ACQUIRE, "agent");
            asm volatile("s_waitcnt vmcnt(0)" ::: "memory");
        }
    }
    __syncthreads();
}

struct Args { const float* in[26]; float* out; unsigned char* ws; int ph_lo, ph_hi; };

struct Frame {
    LAS unsigned char* lds;
    int tid, lane, wave, G, bid;
    const float* const* in;
    float* out; unsigned char* ws;
};

DI int row_cond(int row) { return row < NCTX ? 0 : 1 + ((row - NCTX) >> 10); }

enum { K_STD = 0, K_SPLIT2, K_POOL, K_F1, K_F2C, K_F2L };
enum { E_ML = 0, E_BF16, E_RELU2, E_F32SPLIT, E_POOL, E_F1, E_F2 };

template <int SKIND> struct Sched {
    int G, c, n_units, nN, nt;
    const bf16_t* A; const bf16_t* Bt; int lda, ldb;
    DI static void std_tile(int L, int nM, int nN, int& pm, int& pn) {
        const int nwg = nM * nN; int wgid = L;
        { const int q = nwg / 8, r = nwg % 8, xcd = wgid % 8, off = wgid / 8; wgid = (xcd < r ? xcd * (q + 1) : r * (q + 1) + (xcd - r) * q) + off; }
        const int nig = 8 * nN, gid = wgid / nig, fm = gid * 8, gsz = (nM - fm) < 8 ? (nM - fm) : 8;
        pm = fm + ((wgid % nig) % gsz); pn = (wgid % nig) / gsz;
    }
    DI bool next(int i, pg8::Unit& u) const {
        const int L = i * G + c; if (L >= n_units) return false;
        int pm = 0, pn = 0; u.aux = 0; u.nt = nt;
        if constexpr (SKIND == K_STD) { std_tile(L, 32, nN, pm, pn);
            u.a = (const char*)(A + (size_t)pm * 256 * lda); u.b = (const char*)(Bt + (size_t)pn * 256 * ldb); }
        else if constexpr (SKIND == K_SPLIT2) { const int ks = L >> 7; std_tile(L & 127, 32, 4, pm, pn);
            u.a = (const char*)(A + (size_t)pm * 256 * lda + (size_t)ks * nt * 64); u.b = (const char*)(Bt + (size_t)pn * 256 * ldb + (size_t)ks * nt * 64); u.aux = ks; }
        else if constexpr (SKIND == K_POOL) { const int g = L & 3; pm = L >> 2; pn = g;
            u.a = (const char*)(A + (size_t)pm * 256 * lda + g * 256); u.b = (const char*)(Bt + (size_t)g * 65536); }
        else if constexpr (SKIND == K_F1) { const int tt = L >> 3, r = L & 7, g = r >> 1, part = r & 1; pm = part; pn = tt; u.aux = g;
            u.a = (const char*)(A + (size_t)part * 256 * 256); u.b = (const char*)(Bt + (size_t)tt * 256 * ldb + g * 256); }
        else if constexpr (SKIND == K_F2C) { const int b = L >> 2; pn = L & 3; pm = b; u.aux = 0;
            u.a = (const char*)A; u.b = (const char*)(Bt + (size_t)b * (1024 * 512) + (size_t)pn * 256 * 512); }
        else { const int b = L >> 4, pml = (L >> 2) & 3; pn = L & 3; pm = 16 + b * 4 + pml; u.aux = 1;
            u.a = (const char*)(A + (size_t)pml * 256 * 2048); u.b = (const char*)(Bt + (size_t)b * (1024 * 2048) + (size_t)pn * 256 * 2048); }
        u.pm = pm; u.pn = pn; return true;
    }
};

template <int EKIND> struct Epi {
    bf16_t* ob; float* of; int ldc;
    const float* p0; const float* p1;
    template <int KIND> DI void store4(const pg8::Unit& u, int row, int col, f32x4 v) const {
        if (KIND == E_ML) {
            if (col < 3072) {
                if (col >= 512 && col < 1024) v = v * 0.125f;
                u32x2 w; w.x = pk2(v[0], v[1]); w.y = pk2(v[2], v[3]);
                *(u32x2*)(ob + (size_t)row * 3072 + col) = w;
            } else {
                const int cc = col - 3072;
                if (cc < 32) {
                    f32x4 g = v + *(const f32x4*)(p0 + cc);
                    if ((cc >> 3) & 1) {
#pragma unroll
                        for (int j = 0; j < 4; ++j) { const float x = g[j]; g[j] = fminf(x, 0.f) - log1pf(expf(-fabsf(x))); }
                    }
                    *(f32x4*)(of + (size_t)row * 32 + cc) = g;
                }
            }
        } else if (KIND == E_BF16) {
            u32x2 w; w.x = pk2(v[0], v[1]); w.y = pk2(v[2], v[3]);
            *(u32x2*)(ob + (size_t)row * ldc + col) = w;
        } else if (KIND == E_RELU2) {
#pragma unroll
            for (int j = 0; j < 4; ++j) { const float r = fmaxf(v[j], 0.f); v[j] = r * r; }
            u32x2 w; w.x = pk2(v[0], v[1]); w.y = pk2(v[2], v[3]);
            *(u32x2*)(ob + (size_t)row * ldc + col) = w;
        } else if (KIND == E_F32SPLIT) {
            *(f32x4*)(of + (size_t)u.aux * ((size_t)MTOK * D) + (size_t)row * D + col) = v;
        } else if (KIND == E_POOL) {
            const f32x4 b = *(const f32x4*)(p0 + col), s = *(const f32x4*)(p1 + col);
            *(f32x4*)(of + (size_t)row * D + col) = (v + b) * s;
        } else if (KIND == E_F1) {
            const int part = row >> 8, cp = row & 255, n = u.aux * 256 + cp;
            size_t dst;
            if (col < NCTX) { const int b = col >> 8, s = col & 255; dst = (size_t)b * (1024 * 512) + (size_t)n * 512 + part * 256 + s; }
            else { const int t = col - NCTX, b = t >> 10, s = t & 1023; dst = (size_t)16 * (1024 * 512) + (size_t)b * (1024 * 2048) + (size_t)n * 2048 + part * 1024 + s; }
            u32x2 w; w.x = pk2(v[0], v[1]); w.y = pk2(v[2], v[3]);
            *(u32x2*)(ob + dst) = w;
        } else {
            const float sc = u.aux ? (1.0f / 512.0f) : (1.0f / 256.0f);
            v = v * sc;
            u32x2 w; w.x = pk2(v[0], v[1]); w.y = pk2(v[2], v[3]);
            *(u32x2*)(ob + (size_t)row * D + col) = w;
        }
    }
    template <int KIND> DI void run(const f32x4 (&acc)[2][2][4][2], const pg8::Unit& u, int wr, int wc, int fr, int fq) const {
        const int row0 = u.pm * 256 + wr * 64 + fr, col0 = u.pn * 256 + wc * 32 + 4 * fq;
#pragma unroll
        for (int ai = 0; ai < 2; ++ai)
#pragma unroll
            for (int m = 0; m < 4; ++m)
#pragma unroll
                for (int bj = 0; bj < 2; ++bj)
#pragma unroll
                    for (int n = 0; n < 2; ++n) store4<KIND>(u, row0 + ai * 128 + m * 16, col0 + bj * 128 + n * 16, acc[ai][bj][m][n]);
    }
    DI void operator()(const f32x4 (&acc)[2][2][4][2], const pg8::Unit& u, int wr, int wc, int fr, int fq) const { run<EKIND>(acc, u, wr, wc, fr, fq); }
};

#ifdef NAIVE_GEMM
template <int SKIND, int EKIND> DI void gemm_run(Frame& F, const Sched<SKIND>& S, const Epi<EKIND>& E) {
    pg8::Unit u;
    for (int i = 0; S.next(i, u); ++i) {
        const bf16_t* A = (const bf16_t*)u.a; const bf16_t* B = (const bf16_t*)u.b; const int K = u.nt * 64;
        for (int e = F.tid; e < 256 * 64; e += NTHR) {
            const int r = e >> 6, c4 = (e & 63) * 4;
            f32x4 acc = (f32x4){0.f, 0.f, 0.f, 0.f};
            for (int k = 0; k < K; ++k) { const float a = bf2f(A[(size_t)r * S.lda + k]);
#pragma unroll
                for (int j = 0; j < 4; ++j) acc[j] += a * bf2f(B[(size_t)(c4 + j) * S.ldb + k]); }
            E.template store4<EKIND>(u, u.pm * 256 + r, u.pn * 256 + c4, acc);
        }
    }
}
#else
template <int SKIND, int EKIND> DI void gemm_run(Frame& F, const Sched<SKIND>& S, const Epi<EKIND>& E) { pg8::gemm_phase<Epi<EKIND>, Sched<SKIND>>(F.lds, F.tid, S.lda, S.ldb, S, E); }
#endif

DI float wave_sum(float v) {
#pragma unroll
    for (int o = 1; o < 64; o <<= 1) v += __shfl_xor(v, o);
    return v;
}
DI float wave_max(float v) {
#pragma unroll
    for (int o = 1; o < 64; o <<= 1) v = fmaxf(v, __shfl_xor(v, o));
    return v;
}
DI void p0_transpose_item(const float* W, int K, int N, bf16_t* WT, int row_off, LAS float* scr, int item, int lane) {
    const int nblk = N / 32, kb = item / nblk, nb = item % nblk, k0 = 64 * kb, n0 = 32 * nb;
#pragma unroll 8
    for (int i = 0; i < 32; ++i) { const int kk = 2 * i + (lane >> 5); scr[kk * 33 + (lane & 31)] = W[(size_t)(k0 + kk) * N + n0 + (lane & 31)]; }
    asm volatile("s_waitcnt lgkmcnt(0)" ::: "memory");
    const int c = lane & 7;
#pragma unroll
    for (int j = 0; j < 4; ++j) { const int n = (lane >> 3) + 8 * j; const LAS float* s = scr + (8 * c) * 33 + n;
        u32x4 o; o.x = pk2(s[0 * 33], s[1 * 33]); o.y = pk2(s[2 * 33], s[3 * 33]); o.z = pk2(s[4 * 33], s[5 * 33]); o.w = pk2(s[6 * 33], s[7 * 33]);
        *(u32x4*)(WT + (size_t)(row_off + n0 + n) * K + k0 + 8 * c) = o; }
    asm volatile("s_waitcnt lgkmcnt(0)" ::: "memory");
}

DI void phase_prologue_a(Frame& F) {
    const float* const* in = F.in;
    {
        LAS float* sl = (LAS float*)(F.lds + 71680);
        LAS f32x4* red = (LAS f32x4*)(F.lds + 92160);
        for (int e = F.tid; e < NCOND * D; e += NTHR) { const int cd = e >> 10, k = e & 1023; const float c = cd == 0 ? in[6][k] : in[5][(cd - 1) * D + k]; sl[e] = c / (1.0f + expf(-c)); }
        __syncthreads();
        float* MOD = (float*)(F.ws + WS_MOD);
        for (int item = F.bid; item < 256; item += F.G) {
            const int colg = item * 96, l = colg / NMOD, n0 = colg % NMOD;
            const int cg = F.tid % 24, kg = F.tid / 24;
            f32x4 acc[NCOND];
#pragma unroll
            for (int c = 0; c < NCOND; ++c) acc[c] = (f32x4){0.f, 0.f, 0.f, 0.f};
            if (kg < 21) {
                const float* wp = in[7] + (size_t)l * D * NMOD + n0 + cg * 4;
#pragma unroll 7
                for (int k = kg; k < D; k += 21) { const f32x4 w = *(const f32x4*)(wp + (size_t)k * NMOD);
#pragma unroll
                    for (int c = 0; c < NCOND; ++c) acc[c] += w * sl[c * D + k]; }
#pragma unroll
                for (int c = 0; c < NCOND; ++c) red[(kg * NCOND + c) * 24 + cg] = acc[c];
            }
            __syncthreads();
            if (F.tid < NCOND * 24) { const int c = F.tid / 24, g = F.tid % 24; f32x4 s = *(const f32x4*)(in[8] + (size_t)l * NMOD + n0 + g * 4);
                for (int q = 0; q < 21; ++q) s += red[(q * NCOND + c) * 24 + g];
                *(f32x4*)(MOD + ((size_t)l * NCOND + c) * NMOD + n0 + g * 4) = s; }
            __syncthreads();
        }
    }
    __syncthreads();
    {
        LAS float* scr = (LAS float*)(F.lds + F.wave * 8704);
        const int gw = F.bid * NWAVES + F.wave, NGW = F.G * NWAVES;
        bf16_t* wt_mlin = (bf16_t*)(F.ws + WS_WT_MLIN);
        for (int it = gw; it < 21136; it += NGW) {
            int r = it;
            if (r < 1536) { p0_transpose_item(in[13], 1024, 3072, wt_mlin, 0, scr, r, F.lane); continue; } r -= 1536;
            if (r < 16)   { p0_transpose_item(in[14], 1024, 32, wt_mlin, 3072, scr, r, F.lane); continue; } r -= 16;
            if (r < 512)  { p0_transpose_item(in[17], 1024, 1024, (bf16_t*)(F.ws + WS_WT_MLOUT), 0, scr, r, F.lane); continue; } r -= 512;
            if (r < 1536) { p0_transpose_item(in[18], 1024, 3072, (bf16_t*)(F.ws + WS_WT_SCIN), 0, scr, r, F.lane); continue; } r -= 1536;
            if (r < 512)  { p0_transpose_item(in[20], 1024, 1024, (bf16_t*)(F.ws + WS_WT_SCOUT), 0, scr, r, F.lane); continue; } r -= 512;
            if (r < 512)  { p0_transpose_item(in[24], 1024, 1024, (bf16_t*)(F.ws + WS_WT_FT), 0, scr, r, F.lane); continue; } r -= 512;
            if (r < 128)  { const int g = r >> 5; p0_transpose_item(in[21] + (size_t)g * 65536, 256, 256, (bf16_t*)(F.ws + WS_WT_PL) + (size_t)g * 65536, 0, scr, r & 31, F.lane); continue; } r -= 128;
            if (r < 8192) { const int l = r >> 11; p0_transpose_item(in[11] + (size_t)l * D * FF, 1024, 4096, (bf16_t*)(F.ws + WS_WT_W1) + (size_t)l * D * FF, 0, scr, r & 2047, F.lane); continue; } r -= 8192;
            { const int l = r >> 11; p0_transpose_item(in[12] + (size_t)l * D * FF, 4096, 1024, (bf16_t*)(F.ws + WS_WT_W2) + (size_t)l * D * FF, 0, scr, r & 2047, F.lane); }
        }
        const int gt = F.bid * NTHR + F.tid, NGT = F.G * NTHR;
        u32x4* z = (u32x4*)(wt_mlin + (size_t)3104 * 1024);
        for (int i = gt; i < 224 * 1024 / 8; i += NGT) z[i] = (u32x4){0u, 0u, 0u, 0u};
        bf16_t* WC = (bf16_t*)(F.ws + WS_WC); bf16_t* T256 = (bf16_t*)(F.ws + WS_T256); bf16_t* T1024 = (bf16_t*)(F.ws + WS_T1024);
        for (int i = gt; i < 512 * 256; i += NGT) {
            { const int row = i >> 8, k = i & 255, part = row >> 8, c = row & 255; const int r = (c * k) & 255; float sn, cs; sincospif((float)r * (2.0f / 256.0f), &sn, &cs); WC[i] = (bf16_t)f2bf(part ? sn : cs); }
            { const int sp = i >> 9, col = i & 511, part = col >> 8, s = col & 255; const int r = (sp * s) & 255; float sn, cs; sincospif((float)r * (2.0f / 256.0f), &sn, &cs); T256[i] = (bf16_t)f2bf(part ? -sn : cs); }
        }
        for (int i = gt; i < 1024 * 2048; i += NGT) { const int sp = i >> 11, col = i & 2047, part = col >> 10, s = col & 1023; const int r = (sp * s) & 1023; float sn, cs; sincospif((float)r * (2.0f / 1024.0f), &sn, &cs); T1024[i] = (bf16_t)f2bf(part ? -sn : cs); }
    }
}

DI void phase_prologue_b(Frame& F) {
    const int gw = F.bid * NWAVES + F.wave, NGW = F.G * NWAVES;
    const float* MOD = (const float*)(F.ws + WS_MOD);
    bf16_t* H = (bf16_t*)(F.ws + WS_H);
    for (int row = gw; row < MTOK; row += NGW) {
        const int cd = row_cond(row);
        const float* src = row < NCTX ? F.in[0] + (size_t)row * D : F.in[1] + (size_t)(row - NCTX) * D;
        const float* md = MOD + (size_t)cd * NMOD;
        int gr = 0, gc = 0; if (row >= NCTX) { const int t = (row - NCTX) & 1023; gr = t >> 6; gc = t & 63; }
#pragma unroll
        for (int j = 0; j < 4; ++j) {
            const int col = 4 * F.lane + 256 * j;
            f32x4 v = *(const f32x4*)(src + col);
            if (row >= NCTX) {
                const int quarter = j;
#pragma unroll
                for (int e = 0; e < 4; ++e) { const int jj = (col + e) & 255; const float omega = expf(-(float)jj * (9.210340371976184f / 256.0f));
                    const float arg = (float)(quarter < 2 ? gr : gc) * omega; v[e] += (quarter & 1) ? cosf(arg) : sinf(arg); }
            }
            *(f32x4*)(F.out + (size_t)row * D + col) = v;
            const f32x4 sh = *(const f32x4*)(md + col), sc = *(const f32x4*)(md + D + col);
            const f32x4 h = v * (sc + 1.0f) + sh;
            u32x2 w; w.x = pk2(h[0], h[1]); w.y = pk2(h[2], h[3]);
            *(u32x2*)(H + (size_t)row * D + col) = w;
        }
    }
}

DI void phase_ln(Frame& F, int l, int sub, int nsplit, const float* bias) {
    const int gw = F.bid * NWAVES + F.wave, NGW = F.G * NWAVES;
    const float* MOD = (const float*)(F.ws + WS_MOD);
    const float* Y = (const float*)(F.ws + WS_Y);
    bf16_t* H = (bf16_t*)(F.ws + WS_H);
    const float* lg = F.in[9] + (size_t)(l * 2 + sub) * D; const float* lb = F.in[10] + (size_t)(l * 2 + sub) * D;
    const int goff = sub == 0 ? 2 * D : 5 * D;
    const bool has_next = !(l == 3 && sub == 1);
    const int nl = sub == 0 ? l : l + 1, shoff = sub == 0 ? 3 * D : 0, scoff = sub == 0 ? 4 * D : D;
    for (int row = gw; row < MTOK; row += NGW) {
        const int cd = row_cond(row);
        const float* md = MOD + ((size_t)l * NCOND + cd) * NMOD;
        f32x4 v[4]; float s = 0.f;
#pragma unroll
        for (int j = 0; j < 4; ++j) {
            const int col = 4 * F.lane + 256 * j;
            f32x4 y = *(const f32x4*)(Y + (size_t)row * D + col);
            if (nsplit > 1) y += *(const f32x4*)(Y + (size_t)MTOK * D + (size_t)row * D + col);
            if (bias) y += *(const f32x4*)(bias + col);
            const f32x4 x = *(const f32x4*)(F.out + (size_t)row * D + col);
            const f32x4 g = *(const f32x4*)(md + goff + col);
            v[j] = x * ALPHA + g * y;
            s += (v[j][0] + v[j][1]) + (v[j][2] + v[j][3]);
        }
        const float mean = wave_sum(s) * (1.f / D); float s2 = 0.f;
#pragma unroll
        for (int j = 0; j < 4; ++j) { v[j] = v[j] - mean; s2 += (v[j][0] * v[j][0] + v[j][1] * v[j][1]) + (v[j][2] * v[j][2] + v[j][3] * v[j][3]); }
        const float rstd = 1.f / sqrtf(wave_sum(s2) * (1.f / D) + LN_EPS);
        const float* mdn = MOD + ((size_t)(has_next ? nl : 0) * NCOND + cd) * NMOD;
#pragma unroll
        for (int j = 0; j < 4; ++j) {
            const int col = 4 * F.lane + 256 * j;
            const f32x4 xn = v[j] * rstd * *(const f32x4*)(lg + col) + *(const f32x4*)(lb + col);
            *(f32x4*)(F.out + (size_t)row * D + col) = xn;
            if (has_next) {
                const f32x4 sh = *(const f32x4*)(mdn + shoff + col), sc = *(const f32x4*)(mdn + scoff + col);
                const f32x4 h = xn * (sc + 1.0f) + sh;
                u32x2 w; w.x = pk2(h[0], h[1]); w.y = pk2(h[2], h[3]);
                *(u32x2*)(H + (size_t)row * D + col) = w;
            }
        }
    }
}

DI void phase_s1(Frame& F) {
    LAS float* kf = (LAS float*)F.lds;
    LAS float* vf = kf + 64 * 65;
    LAS float* wv = vf + 64 * 128;
    LAS float* gl = wv + 128;
    LAS float* red = gl + 256;
    const bf16_t* QKVO = (const bf16_t*)(F.ws + WS_QKVO);
    const float* GATES = (const float*)(F.ws + WS_GATES);
    float* L = (float*)(F.ws + WS_L); float* NL = (float*)(F.ws + WS_NL); float* MLOC = (float*)(F.ws + WS_MLOC); float* BLAST = (float*)(F.ws + WS_BLAST);
    const int tid = F.tid;
    for (int item = F.bid; item < 1024; item += F.G) {
        const int gb = item >> 3, h = item & 7, row0 = gb * 64;
        __syncthreads();
        { const int j = tid >> 3, c8 = (tid & 7) * 8;
          const u32x4 kk = *(const u32x4*)(QKVO + (size_t)(row0 + j) * 3072 + 512 + h * 64 + c8);
#pragma unroll
          for (int e = 0; e < 4; ++e) { kf[j * 65 + c8 + 2 * e] = __uint_as_float(kk[e] << 16); kf[j * 65 + c8 + 2 * e + 1] = __uint_as_float(kk[e] & 0xffff0000u); }
          const int c16 = (tid & 7) * 16;
#pragma unroll
          for (int q = 0; q < 2; ++q) { const u32x4 vv = *(const u32x4*)(QKVO + (size_t)(row0 + j) * 3072 + 1024 + h * 128 + c16 + q * 8);
#pragma unroll
              for (int e = 0; e < 4; ++e) { vf[j * 128 + c16 + q * 8 + 2 * e] = __uint_as_float(vv[e] << 16); vf[j * 128 + c16 + q * 8 + 2 * e + 1] = __uint_as_float(vv[e] & 0xffff0000u); } }
          if (tid < 256) { const int d = tid >> 7, io = (tid >> 6) & 1, jj = tid & 63; gl[(io * 2 + d) * 64 + jj] = GATES[(size_t)(row0 + jj) * 32 + d * 16 + io * 8 + h]; } }
        __syncthreads();
        if (tid < 128) {
            const int d = tid >> 6, j = tid & 63; const LAS float* lf = gl + (2 + d) * 64;
            float e = 0.f, tot = 0.f;
            for (int u = 0; u < 64; ++u) { const float f = lf[u]; tot += f; if (d == 0 ? (u > j) : (u < j)) e += f; }
            const float a = e + gl[d * 64 + j];
            const float mloc = wave_max(a);
            wv[d * 64 + j] = expf(a - mloc);
            if (j == 0) { red[d] = mloc; red[2 + d] = tot; }
        }
        __syncthreads();
        const int dq = tid >> 3, vg = tid & 7;
        f32x4 a0[4], a1[4]; float n0 = 0.f, n1 = 0.f;
#pragma unroll
        for (int q = 0; q < 4; ++q) { a0[q] = (f32x4){0.f, 0.f, 0.f, 0.f}; a1[q] = (f32x4){0.f, 0.f, 0.f, 0.f}; }
        for (int j = 0; j < 64; ++j) {
            const float kk = kf[j * 65 + dq]; const float w0 = wv[j] * kk, w1 = wv[64 + j] * kk; n0 += w0; n1 += w1;
#pragma unroll
            for (int q = 0; q < 4; ++q) { const f32x4 vv = *(const LAS f32x4*)(vf + j * 128 + vg * 16 + q * 4); a0[q] += vv * w0; a1[q] += vv * w1; }
        }
        const size_t idx0 = (size_t)(gb * 8 + h) * 2;
#pragma unroll
        for (int q = 0; q < 4; ++q) { *(f32x4*)(L + idx0 * 8192 + dq * 128 + vg * 16 + q * 4) = a0[q]; *(f32x4*)(L + (idx0 + 1) * 8192 + dq * 128 + vg * 16 + q * 4) = a1[q]; }
        if (vg == 0) { NL[idx0 * 64 + dq] = n0; NL[(idx0 + 1) * 64 + dq] = n1; }
        if (tid < 2) { MLOC[idx0 + tid] = red[tid]; BLAST[idx0 + tid] = red[2 + tid]; }
    }
}

DI void phase_s2(Frame& F) {
    const float* L = (const float*)(F.ws + WS_L); const float* NL = (const float*)(F.ws + WS_NL);
    const float* MLOC = (const float*)(F.ws + WS_MLOC); const float* BLAST = (const float*)(F.ws + WS_BLAST);
    float* CINIT = (float*)(F.ws + WS_H1); float* NINIT = (float*)(F.ws + WS_NINIT); float* MINIT = (float*)(F.ws + WS_MINIT);
    const int tid = F.tid;
    for (int item = F.bid; item < 1280; item += F.G) {
        const int st = item >> 2, slab = item & 3, seq = st >> 4, h = (st >> 1) & 7, d = st & 1;
        const int e4 = (slab * 512 + tid) * 4;
        const int NC = seq < 16 ? 4 : 16, gb0 = seq < 16 ? seq * 4 : 64 + (seq - 16) * 16;
        const bool nthread = (slab == 0 && tid < 64);
        f32x4 C = (f32x4){0.f, 0.f, 0.f, 0.f}; float n = 0.f, m = 0.f;
        if (seq >= 16) { const size_t base = (size_t)((seq - 16) * 2 + d) * 8 + h; C = *(const f32x4*)(F.in[2] + base * 8192 + e4); if (nthread) n = F.in[3][base * 64 + tid]; m = F.in[4][base]; }
        for (int c = 0; c < NC; ++c) {
            const int gb = d == 0 ? gb0 + c : gb0 + NC - 1 - c; const size_t idx = (size_t)(gb * 8 + h) * 2 + d;
            *(f32x4*)(CINIT + idx * 8192 + e4) = C;
            if (nthread) NINIT[idx * 64 + tid] = n;
            if (slab == 0 && tid == 0) MINIT[idx] = m;
            const float bl = BLAST[idx], ml = MLOC[idx], mn = fmaxf(bl + m, ml), f1 = expf(bl + m - mn), f2 = expf(ml - mn);
            C = C * f1 + *(const f32x4*)(L + idx * 8192 + e4) * f2;
            if (nthread) n = n * f1 + NL[idx * 64 + tid] * f2;
            m = mn;
        }
        if (seq < 16) { const size_t ob = (size_t)(seq * 2 + d) * 8 + h; *(f32x4*)(F.out + OUT_NEWC + ob * 8192 + e4) = C; if (nthread) F.out[OUT_NEWN + ob * 64 + tid] = n; if (slab == 0 && tid == 0) F.out[OUT_NEWM + ob] = m; }
    }
}

DI void phase_s3(Frame& F) {
    LAS float* qf = (LAS float*)F.lds;
    LAS float* kf = qf + 64 * 65;
    LAS float* vf = kf + 64 * 65;
    LAS float* Cf = vf + 64 * 128;
    LAS float* Cb = Cf + 64 * 128;
    LAS float* gl = Cb + 64 * 128;
    LAS float* cum = gl + 256;
    LAS float* suf = cum + 64;
    LAS float* nfb = suf + 64;
    const bf16_t* QKVO = (const bf16_t*)(F.ws + WS_QKVO);
    const float* GATES = (const float*)(F.ws + WS_GATES);
    const float* CINIT = (const float*)(F.ws + WS_H1); const float* NINIT = (const float*)(F.ws + WS_NINIT); const float* MINIT = (const float*)(F.ws + WS_MINIT);
    bf16_t* HS = (bf16_t*)(F.ws + WS_HS);
    const float* norm_g = F.in[16];
    const int tid = F.tid;
    for (int item = F.bid; item < 1024; item += F.G) {
        const int gb = item >> 3, h = item & 7, row0 = gb * 64;
        const size_t idx0 = (size_t)(gb * 8 + h) * 2;
        __syncthreads();
        { const int j = tid >> 3, c8 = (tid & 7) * 8;
          const u32x4 qq = *(const u32x4*)(QKVO + (size_t)(row0 + j) * 3072 + h * 64 + c8);
          const u32x4 kk = *(const u32x4*)(QKVO + (size_t)(row0 + j) * 3072 + 512 + h * 64 + c8);
#pragma unroll
          for (int e = 0; e < 4; ++e) { qf[j * 65 + c8 + 2 * e] = __uint_as_float(qq[e] << 16); qf[j * 65 + c8 + 2 * e + 1] = __uint_as_float(qq[e] & 0xffff0000u);
                                        kf[j * 65 + c8 + 2 * e] = __uint_as_float(kk[e] << 16); kf[j * 65 + c8 + 2 * e + 1] = __uint_as_float(kk[e] & 0xffff0000u); }
          const int c16 = (tid & 7) * 16;
#pragma unroll
          for (int q = 0; q < 2; ++q) { const u32x4 vv = *(const u32x4*)(QKVO + (size_t)(row0 + j) * 3072 + 1024 + h * 128 + c16 + q * 8);
#pragma unroll
              for (int e = 0; e < 4; ++e) { vf[j * 128 + c16 + q * 8 + 2 * e] = __uint_as_float(vv[e] << 16); vf[j * 128 + c16 + q * 8 + 2 * e + 1] = __uint_as_float(vv[e] & 0xffff0000u); } }
          if (tid < 256) { const int d = tid >> 7, io = (tid >> 6) & 1, jj = tid & 63; gl[(io * 2 + d) * 64 + jj] = GATES[(size_t)(row0 + jj) * 32 + d * 16 + io * 8 + h]; }
          if (tid < 128) nfb[tid] = NINIT[(idx0 + (tid >> 6)) * 64 + (tid & 63)];
#pragma unroll
          for (int q = 0; q < 4; ++q) { const int e = tid * 4 + q * 2048; *(LAS f32x4*)(Cf + e) = *(const f32x4*)(CINIT + idx0 * 8192 + e); *(LAS f32x4*)(Cb + e) = *(const f32x4*)(CINIT + (idx0 + 1) * 8192 + e); } }
        const float mf = MINIT[idx0], mb = MINIT[idx0 + 1];
        __syncthreads();
        if (tid < 64) { float s = 0.f; for (int u = 0; u <= tid; ++u) s += gl[2 * 64 + u]; cum[tid] = s; }
        else if (tid < 128) { const int j = tid - 64; float s = 0.f; for (int u = j; u < 64; ++u) s += gl[3 * 64 + u]; suf[j] = s; }
        __syncthreads();
        const int t = tid >> 3, sub = tid & 7;
        float sr[8];
#pragma unroll
        for (int i = 0; i < 8; ++i) sr[i] = 0.f;
        float qnf = 0.f, qnb = 0.f;
        for (int dd = 0; dd < 64; ++dd) { const float qv = qf[t * 65 + dd];
#pragma unroll
            for (int i = 0; i < 8; ++i) sr[i] += qv * kf[(sub * 8 + i) * 65 + dd]; }
#pragma unroll
        for (int i = 0; i < 8; ++i) { const float qv = qf[t * 65 + sub * 8 + i]; qnf += qv * nfb[sub * 8 + i]; qnb += qv * nfb[64 + sub * 8 + i]; }
        qnf += __shfl_xor(qnf, 1); qnf += __shfl_xor(qnf, 2); qnf += __shfl_xor(qnf, 4);
        qnb += __shfl_xor(qnb, 1); qnb += __shfl_xor(qnb, 2); qnb += __shfl_xor(qnb, 4);
        const float ct = cum[t], stt = suf[t];
        float df[8], db[8]; float mxf = ct + mf, mxb = stt + mb;
#pragma unroll
        for (int i = 0; i < 8; ++i) { const int s = sub * 8 + i;
            df[i] = (s <= t) ? (ct - cum[s] + gl[s]) : -INFINITY; db[i] = (s >= t) ? (stt - suf[s] + gl[64 + s]) : -INFINITY;
            mxf = fmaxf(mxf, df[i]); mxb = fmaxf(mxb, db[i]); }
        mxf = fmaxf(mxf, __shfl_xor(mxf, 1)); mxf = fmaxf(mxf, __shfl_xor(mxf, 2)); mxf = fmaxf(mxf, __shfl_xor(mxf, 4));
        mxb = fmaxf(mxb, __shfl_xor(mxb, 1)); mxb = fmaxf(mxb, __shfl_xor(mxb, 2)); mxb = fmaxf(mxb, __shfl_xor(mxb, 4));
        float pf[8], pb[8], sumf = 0.f, sumb = 0.f;
#pragma unroll
        for (int i = 0; i < 8; ++i) { const int s = sub * 8 + i;
            pf[i] = (s <= t) ? sr[i] * expf(df[i] - mxf) : 0.f; pb[i] = (s >= t) ? sr[i] * expf(db[i] - mxb) : 0.f; sumf += pf[i]; sumb += pb[i]; }
        sumf += __shfl_xor(sumf, 1); sumf += __shfl_xor(sumf, 2); sumf += __shfl_xor(sumf, 4);
        sumb += __shfl_xor(sumb, 1); sumb += __shfl_xor(sumb, 2); sumb += __shfl_xor(sumb, 4);
        const float af = expf(ct + mf - mxf), ab = expf(stt + mb - mxb);
        const float rf = 1.0f / fmaxf(fabsf(sumf + af * qnf), expf(-mxf)), rb = 1.0f / fmaxf(fabsf(sumb + ab * qnb), expf(-mxb));
        const float cf = af * rf, cb = ab * rb;
        __syncthreads();
        LAS float* Pm = kf;
#pragma unroll
        for (int i = 0; i < 8; ++i) Pm[t * 65 + sub * 8 + i] = pf[i] * rf + pb[i] * rb;
        __syncthreads();
        const int vg = sub;
        f32x4 acc[4];
#pragma unroll
        for (int q = 0; q < 4; ++q) acc[q] = (f32x4){0.f, 0.f, 0.f, 0.f};
        for (int s = 0; s < 64; ++s) { const float p = Pm[t * 65 + s];
#pragma unroll
            for (int q = 0; q < 4; ++q) acc[q] += *(const LAS f32x4*)(vf + s * 128 + vg * 16 + q * 4) * p; }
        for (int dd = 0; dd < 64; ++dd) { const float qv = qf[t * 65 + dd]; const float a = qv * cf, b = qv * cb;
#pragma unroll
            for (int q = 0; q < 4; ++q) acc[q] += *(const LAS f32x4*)(Cf + dd * 128 + vg * 16 + q * 4) * a + *(const LAS f32x4*)(Cb + dd * 128 + vg * 16 + q * 4) * b; }
        float sm = 0.f;
#pragma unroll
        for (int q = 0; q < 4; ++q) sm += (acc[q][0] + acc[q][1]) + (acc[q][2] + acc[q][3]);
        sm += __shfl_xor(sm, 1); sm += __shfl_xor(sm, 2); sm += __shfl_xor(sm, 4);
        const float mu = sm * (1.0f / 128.0f); float vs = 0.f;
#pragma unroll
        for (int q = 0; q < 4; ++q) { acc[q] = acc[q] - mu; vs += (acc[q][0] * acc[q][0] + acc[q][1] * acc[q][1]) + (acc[q][2] * acc[q][2] + acc[q][3] * acc[q][3]); }
        vs += __shfl_xor(vs, 1); vs += __shfl_xor(vs, 2); vs += __shfl_xor(vs, 4);
        const float rstd = 1.0f / sqrtf(vs * (1.0f / 128.0f) + LN_EPS);
        const size_t orow = (size_t)(row0 + t);
#pragma unroll
        for (int q2 = 0; q2 < 2; ++q2) {
            const u32x4 ov = *(const u32x4*)(QKVO + orow * 3072 + 2048 + h * 128 + vg * 16 + q2 * 8);
            u32x4 w;
#pragma unroll
            for (int e = 0; e < 4; ++e) {
                const int q = q2 * 2 + (e >> 1), i0 = (e & 1) * 2;
                const float g0 = norm_g[h * 128 + vg * 16 + q * 4 + i0], g1 = norm_g[h * 128 + vg * 16 + q * 4 + i0 + 1];
                const float o0 = __uint_as_float(ov[e] << 16), o1 = __uint_as_float(ov[e] & 0xffff0000u);
                w[e] = pk2(acc[q][i0] * rstd * g0 * sigmoidf_(o0), acc[q][i0 + 1] * rstd * g1 * sigmoidf_(o1));
            }
            *(u32x4*)(HS + orow * D + h * 128 + vg * 16 + q2 * 8) = w;
        }
    }
}

DI void phase_conv(Frame& F) {
    const bf16_t* BCU = (const bf16_t*)(F.ws + WS_QKVO); bf16_t* HS = (bf16_t*)(F.ws + WS_HS);
    const float* cw = F.in[19];
    const int gt = F.bid * NTHR + F.tid, NGT = F.G * NTHR;
    for (int i = gt; i < MTOK * 128; i += NGT) {
        const int row = i >> 7, c8 = (i & 127) * 8;
        const int s = row < NCTX ? (row & 255) : ((row - NCTX) & 1023), S = row < NCTX ? 256 : 1024;
        float accv[8];
#pragma unroll
        for (int e = 0; e < 8; ++e) accv[e] = 0.f;
#pragma unroll
        for (int j = 0; j < 3; ++j) {
            const int ss = s + j - 1;
            if (ss >= 0 && ss < S) {
                const size_t r2 = (size_t)(row + j - 1);
                const u32x4 cg = *(const u32x4*)(BCU + r2 * 3072 + 1024 + c8), uu = *(const u32x4*)(BCU + r2 * 3072 + 2048 + c8);
#pragma unroll
                for (int e = 0; e < 4; ++e) {
                    const float w0 = cw[j * D + c8 + 2 * e], w1 = cw[j * D + c8 + 2 * e + 1];
                    accv[2 * e] += w0 * (__uint_as_float(cg[e] << 16) * __uint_as_float(uu[e] << 16));
                    accv[2 * e + 1] += w1 * (__uint_as_float(cg[e] & 0xffff0000u) * __uint_as_float(uu[e] & 0xffff0000u));
                }
            }
        }
        const u32x4 bg = *(const u32x4*)(BCU + (size_t)row * 3072 + c8);
        u32x4 w;
#pragma unroll
        for (int e = 0; e < 4; ++e) w[e] = pk2(__uint_as_float(bg[e] << 16) * accv[2 * e], __uint_as_float(bg[e] & 0xffff0000u) * accv[2 * e + 1]);
        *(u32x4*)(HS + (size_t)row * D + c8) = w;
    }
}

DI void phase_poolprep(Frame& F) {
    const float* MOD = (const float*)(F.ws + WS_MOD); bf16_t* HS = (bf16_t*)(F.ws + WS_HS);
    const int gt = F.bid * NTHR + F.tid, NGT = F.G * NTHR;
    for (int i = gt; i < MTOK * 256; i += NGT) {
        const int row = i >> 8, c4 = (i & 255) * 4;
        const int cd = row_cond(row);
        const int s = row < NCTX ? (row & 255) : ((row - NCTX) & 1023), S = row < NCTX ? 256 : 1024;
        const float* md = MOD + ((size_t)2 * NCOND + cd) * NMOD;
        const f32x4 sh = *(const f32x4*)(md + c4), sc = *(const f32x4*)(md + D + c4) + 1.0f;
        const int win = 2 << (c4 >> 8);
        int lo = s - win / 2; if (lo < 0) lo = 0; int hi = s + win - win / 2; if (hi > S) hi = S;
        f32x4 sum = (f32x4){0.f, 0.f, 0.f, 0.f};
        for (int u = lo; u < hi; ++u) sum += *(const f32x4*)(F.out + (size_t)(row + u - s) * D + c4) * sc + sh;
        const f32x4 hh = *(const f32x4*)(F.out + (size_t)row * D + c4) * sc + sh;
        const f32x4 p = sum * (1.0f / (float)(hi - lo)) - hh;
        u32x2 w; w.x = pk2(p[0], p[1]); w.y = pk2(p[2], p[3]);
        *(u32x2*)(HS + (size_t)row * D + c4) = w;
    }
}

constexpr int NPHASE = 31;
enum { PK_PRO_A = 0, PK_PRO_B, PK_LN0, PK_UP, PK_DOWN, PK_LN1, PK_ML_IN, PK_S1, PK_S2, PK_S3, PK_OUTPROJ, PK_SC_IN, PK_CONV, PK_POOLPREP, PK_POOLGEMM, PK_F1, PK_F2, PK_COUNT };
template <int SKIND> DI Sched<SKIND> make_sched(Frame& F, const bf16_t* A, int lda, const bf16_t* Bt, int ldb, int n_units, int nN, int nt, int rot) {
    Sched<SKIND> S; S.G = F.G; S.c = (F.bid + rot) % F.G; S.n_units = n_units; S.nN = nN; S.nt = nt; S.A = A; S.Bt = Bt; S.lda = lda; S.ldb = ldb; return S;
}
template <int EKIND> DI Epi<EKIND> make_epi(bf16_t* ob, float* of, int ldc, const float* p0, const float* p1) { Epi<EKIND> E; E.ob = ob; E.of = of; E.ldc = ldc; E.p0 = p0; E.p1 = p1; return E; }

template <int PK> DI void run_kind(Frame& F, int layer) {
    unsigned char* ws = F.ws;
    const bf16_t* H = (const bf16_t*)(ws + WS_H); const bf16_t* HS = (const bf16_t*)(ws + WS_HS);
    if constexpr (PK == PK_PRO_A) phase_prologue_a(F);
    else if constexpr (PK == PK_PRO_B) phase_prologue_b(F);
    else if constexpr (PK == PK_LN0) phase_ln(F, layer, 0, layer == 2 ? 1 : 2, layer == 3 ? F.in[25] : nullptr);
    else if constexpr (PK == PK_LN1) phase_ln(F, layer, 1, 2, nullptr);
    else if constexpr (PK == PK_UP) { auto S = make_sched<K_STD>(F, H, D, (const bf16_t*)(ws + WS_WT_W1) + (size_t)layer * D * FF, D, 512, 16, 16, 0);
        auto E = make_epi<E_RELU2>((bf16_t*)(ws + WS_H1), nullptr, FF, nullptr, nullptr); gemm_run(F, S, E); }
    else if constexpr (PK == PK_DOWN) { auto S = make_sched<K_SPLIT2>(F, (const bf16_t*)(ws + WS_H1), FF, (const bf16_t*)(ws + WS_WT_W2) + (size_t)layer * D * FF, FF, 256, 4, 32, 0);
        auto E = make_epi<E_F32SPLIT>(nullptr, (float*)(ws + WS_Y), 0, nullptr, nullptr); gemm_run(F, S, E); }
    else if constexpr (PK == PK_ML_IN) { auto S = make_sched<K_STD>(F, H, D, (const bf16_t*)(ws + WS_WT_MLIN), D, 32 * 13, 13, 16, 0);
        auto E = make_epi<E_ML>((bf16_t*)(ws + WS_QKVO), (float*)(ws + WS_GATES), 0, F.in[15], nullptr); gemm_run(F, S, E); }
    else if constexpr (PK == PK_S1) phase_s1(F);
    else if constexpr (PK == PK_S2) phase_s2(F);
    else if constexpr (PK == PK_S3) phase_s3(F);
    else if constexpr (PK == PK_OUTPROJ) { const size_t wo = layer == 0 ? WS_WT_MLOUT : (layer == 1 ? WS_WT_SCOUT : WS_WT_FT);
        auto S = make_sched<K_SPLIT2>(F, HS, D, (const bf16_t*)(ws + wo), D, 256, 4, 8, 0);
        auto E = make_epi<E_F32SPLIT>(nullptr, (float*)(ws + WS_Y), 0, nullptr, nullptr); gemm_run(F, S, E); }
    else if constexpr (PK == PK_SC_IN) { auto S = make_sched<K_STD>(F, H, D, (const bf16_t*)(ws + WS_WT_SCIN), D, 32 * 12, 12, 16, 0);
        auto E = make_epi<E_BF16>((bf16_t*)(ws + WS_QKVO), nullptr, 3072, nullptr, nullptr); gemm_run(F, S, E); }
    else if constexpr (PK == PK_CONV) phase_conv(F);
    else if constexpr (PK == PK_POOLPREP) phase_poolprep(F);
    else if constexpr (PK == PK_POOLGEMM) { auto S = make_sched<K_POOL>(F, HS, D, (const bf16_t*)(ws + WS_WT_PL), 256, 128, 4, 4, 0);
        auto E = make_epi<E_POOL>(nullptr, (float*)(ws + WS_Y), 0, F.in[22], F.in[23]); gemm_run(F, S, E); }
    else if constexpr (PK == PK_F1) { auto S = make_sched<K_F1>(F, (const bf16_t*)(ws + WS_WC), 256, H, D, 256, 32, 4, 0);
        auto E = make_epi<E_F1>((bf16_t*)(ws + WS_QKVO), nullptr, 0, nullptr, nullptr); gemm_run(F, S, E); }
    else { auto E = make_epi<E_F2>((bf16_t*)(ws + WS_HS), nullptr, 0, nullptr, nullptr);
        { auto S = make_sched<K_F2L>(F, (const bf16_t*)(ws + WS_T1024), 2048, (const bf16_t*)(ws + WS_QKVO) + (size_t)16 * 1024 * 512, 2048, 64, 4, 32, 0); gemm_run(F, S, E); }
        __syncthreads();
        { auto S = make_sched<K_F2C>(F, (const bf16_t*)(ws + WS_T256), 512, (const bf16_t*)(ws + WS_QKVO), 512, 64, 4, 8, (F.G > 64 ? F.G - 64 : 0)); gemm_run(F, S, E); } }
}

__host__ __device__ inline void phase_of(int ph, int& pk, int& layer) {
    layer = 0;
    if (ph >= 7 && ph <= 10) { layer = 0; pk = PK_LN0 + (ph - 7); return; }
    if (ph >= 14 && ph <= 17) { layer = 1; pk = PK_LN0 + (ph - 14); return; }
    if (ph >= 20 && ph <= 23) { layer = 2; pk = PK_LN0 + (ph - 20); return; }
    if (ph >= 27 && ph <= 30) { layer = 3; pk = PK_LN0 + (ph - 27); return; }
    switch (ph) {
    case 0: pk = PK_PRO_A; break; case 1: pk = PK_PRO_B; break; case 2: pk = PK_ML_IN; break; case 3: pk = PK_S1; break; case 4: pk = PK_S2; break; case 5: pk = PK_S3; break;
    case 6: layer = 0; pk = PK_OUTPROJ; break; case 11: pk = PK_SC_IN; break; case 12: pk = PK_CONV; break; case 13: layer = 1; pk = PK_OUTPROJ; break;
    case 18: pk = PK_POOLPREP; break; case 19: pk = PK_POOLGEMM; break; case 24: pk = PK_F1; break; case 25: pk = PK_F2; break; default: layer = 3; pk = PK_OUTPROJ; break;
    }
}

DI void frame_init(Frame& F, const Args& args, unsigned char* lds_raw) {
    F.lds = (LAS unsigned char*)lds_raw;
    F.tid = threadIdx.x; F.lane = F.tid & 63; F.wave = __builtin_amdgcn_readfirstlane(F.tid >> 6);
    F.G = gridDim.x; F.bid = blockIdx.x;
    F.in = (const float* const*)__builtin_amdgcn_kernarg_segment_ptr();
    F.out = args.out; F.ws = args.ws;
}

DI void frame_launder(Frame& F, const Args& args, unsigned char* lds_raw) {
    size_t z = 0; int p_tid = threadIdx.x, p_bid = blockIdx.x, p_g = gridDim.x;
    asm volatile("" : "+s"(z), "+v"(p_tid), "+s"(p_bid), "+s"(p_g));
    F.in = (const float* const*)((const char*)__builtin_amdgcn_kernarg_segment_ptr() + z); F.out = (float*)((char*)args.out + z); F.ws = args.ws + z;
    F.tid = p_tid; F.lane = p_tid & 63; F.wave = __builtin_amdgcn_readfirstlane(p_tid >> 6); F.bid = p_bid; F.G = p_g;
    F.lds = (LAS unsigned char*)lds_raw + (unsigned)z;
}
__global__ void __launch_bounds__(NTHR, 2) mega_fwd(Args args) {
    extern __shared__ __attribute__((aligned(16))) unsigned char lds_raw[];
    Frame F; frame_init(F, args, lds_raw);
    volatile LAS unsigned* MISC = (volatile LAS unsigned*)(F.lds + LDS_BYTES - 64);
    if (F.tid < 16) MISC[F.tid] = 0u;
    __syncthreads();
    const XcdBarrier bar = xcd_barrier_post((unsigned*)(args.ws + WS_CTL) + 1024, MISC);
#define PHASE(PK, layer) do { frame_launder(F, args, lds_raw); run_kind<PK>(F, (layer)); } while (0)
#define SEAM() xcd_barrier(bar)
    PHASE(PK_PRO_A, 0); SEAM();
    PHASE(PK_PRO_B, 0); SEAM();
    for (int layer = 0; layer < 4; ++layer) {
        if (layer == 0) { PHASE(PK_ML_IN, 0); SEAM(); PHASE(PK_S1, 0); SEAM(); PHASE(PK_S2, 0); SEAM(); PHASE(PK_S3, 0); SEAM(); }
        else if (layer == 1) { PHASE(PK_SC_IN, 1); SEAM(); PHASE(PK_CONV, 1); SEAM(); }
        else if (layer == 2) { PHASE(PK_POOLPREP, 2); SEAM(); PHASE(PK_POOLGEMM, 2); SEAM(); }
        else { PHASE(PK_F1, 3); SEAM(); PHASE(PK_F2, 3); SEAM(); }
        if (layer != 2) { PHASE(PK_OUTPROJ, layer); SEAM(); }
        PHASE(PK_LN0, layer); SEAM();
        PHASE(PK_UP, layer); SEAM();
        PHASE(PK_DOWN, layer); SEAM();
        PHASE(PK_LN1, layer);
        if (layer < 3) SEAM();
    }
#undef PHASE
#undef SEAM
}

template <int PK> __global__ void __launch_bounds__(NTHR, 2) phase_kernel(Args args) {
    extern __shared__ __attribute__((aligned(16))) unsigned char lds_raw[];
    Frame F; frame_init(F, args, lds_raw);
    run_kind<PK>(F, args.ph_lo);
}

template <int PK> static void launch_phase(int grid, const Args& a, hipStream_t stream, bool setattr) {
    if (setattr) { (void)hipFuncSetAttribute((const void*)phase_kernel<PK>, hipFuncAttributeMaxDynamicSharedMemorySize, LDS_BYTES); return; }
    hipLaunchKernelGGL(phase_kernel<PK>, dim3(grid), dim3(NTHR), LDS_BYTES, stream, a);
}
static void launch_kind(int pk, int grid, const Args& a, hipStream_t stream, bool setattr) {
    switch (pk) {
    case PK_PRO_A: launch_phase<PK_PRO_A>(grid, a, stream, setattr); break;
    case PK_PRO_B: launch_phase<PK_PRO_B>(grid, a, stream, setattr); break;
    case PK_LN0: launch_phase<PK_LN0>(grid, a, stream, setattr); break;
    case PK_UP: launch_phase<PK_UP>(grid, a, stream, setattr); break;
    case PK_DOWN: launch_phase<PK_DOWN>(grid, a, stream, setattr); break;
    case PK_LN1: launch_phase<PK_LN1>(grid, a, stream, setattr); break;
    case PK_ML_IN: launch_phase<PK_ML_IN>(grid, a, stream, setattr); break;
    case PK_S1: launch_phase<PK_S1>(grid, a, stream, setattr); break;
    case PK_S2: launch_phase<PK_S2>(grid, a, stream, setattr); break;
    case PK_S3: launch_phase<PK_S3>(grid, a, stream, setattr); break;
    case PK_OUTPROJ: launch_phase<PK_OUTPROJ>(grid, a, stream, setattr); break;
    case PK_SC_IN: launch_phase<PK_SC_IN>(grid, a, stream, setattr); break;
    case PK_CONV: launch_phase<PK_CONV>(grid, a, stream, setattr); break;
    case PK_POOLPREP: launch_phase<PK_POOLPREP>(grid, a, stream, setattr); break;
    case PK_POOLGEMM: launch_phase<PK_POOLGEMM>(grid, a, stream, setattr); break;
    case PK_F1: launch_phase<PK_F1>(grid, a, stream, setattr); break;
    default: launch_phase<PK_F2>(grid, a, stream, setattr); break;
    }
}

extern "C" void kernel_launch(void* const* d_in, const int* in_sizes, int n_in, void* d_out, int out_size, void* d_ws, size_t ws_size, hipStream_t stream) {
    static int grid = 0;
    Args a{};
    if (grid == 0) {
        if (n_in != 26 || out_size != 10502400 || ws_size < WS_END) { fprintf(stderr, "kernel_launch: unexpected shapes (n_in %d out %d ws %zu)\n", n_in, out_size, ws_size); grid = -1; return; }
        int dev = 0, cus = 0;
        if (hipGetDevice(&dev) != hipSuccess || hipDeviceGetAttribute(&cus, hipDeviceAttributeMultiprocessorCount, dev) != hipSuccess) { grid = -1; return; }
#if MK_ONE_LAUNCH
        int per_cu = 0;
        if (hipFuncSetAttribute((const void*)mega_fwd, hipFuncAttributeMaxDynamicSharedMemorySize, LDS_BYTES) != hipSuccess) { fprintf(stderr, "kernel_launch: hipFuncSetAttribute failed\n"); grid = -1; return; }
        if (hipOccupancyMaxActiveBlocksPerMultiprocessor(&per_cu, (const void*)mega_fwd, NTHR, LDS_BYTES) != hipSuccess || per_cu < 1) { fprintf(stderr, "kernel_launch: occupancy query says %d blocks per CU\n", per_cu); (void)hipGetLastError(); grid = -1; return; }
#else
        for (int pk = 0; pk < PK_COUNT; ++pk) launch_kind(pk, 0, a, stream, true);
        (void)hipGetLastError();
#endif
        grid = cus;
    }
    if (grid < 0) return;
    for (int i = 0; i < 26; ++i) a.in[i] = (const float*)d_in[i];
    a.out = (float*)d_out; a.ws = (unsigned char*)d_ws;
#if MK_ONE_LAUNCH
    (void)hipMemsetAsync((char*)d_ws + WS_CTL, 0, CTL_ZERO_BYTES, stream);
    a.ph_lo = 0; a.ph_hi = NPHASE;
    void* kargs[] = {&a};
    hipError_t e = hipLaunchCooperativeKernel((const void*)mega_fwd, dim3(grid), dim3(NTHR), kargs, LDS_BYTES, stream);
    if (e != hipSuccess) fprintf(stderr, "kernel_launch: cooperative launch failed: %s (grid %d)\n", hipGetErrorString(e), grid);
#else
    for (int ph = 0; ph < NPHASE; ++ph) {
        int pk, layer; phase_of(ph, pk, layer);
        a.ph_lo = layer; a.ph_hi = 0;
        launch_kind(pk, grid, a, stream, false);
    }
#endif
}
```

```cpp
#include <hip/hip_runtime.h>
#include <cstdio>
#include <cstdint>

#ifndef MK_ONE_LAUNCH
#define MK_ONE_LAUNCH 1
#endif

#define LAS __attribute__((address_space(3)))
#define GAS __attribute__((address_space(1)))
typedef unsigned short bf16_t;
typedef short bf16x8 __attribute__((ext_vector_type(8)));
typedef float f32x4 __attribute__((ext_vector_type(4)));
typedef float f32x2 __attribute__((ext_vector_type(2)));
typedef unsigned u32x4 __attribute__((ext_vector_type(4)));
typedef unsigned u32x2 __attribute__((ext_vector_type(2)));
#define DI __device__ __forceinline__

constexpr int D = 1024, MTOK = 8192, NCTX = 4096, FF = 4096, NHEAD = 8, DQK = 64, DHV = 128;
constexpr int MLN = 3328;
constexpr int NCOND = 5, NMOD = 6 * D;
constexpr float ALPHA = 1.6817928305074292f;
constexpr float LN_EPS = 1e-5f;
constexpr int NWAVES = 8, NTHR = 512;
constexpr int LDS_BYTES = 147456;

constexpr size_t MiB = 1u << 20;
constexpr size_t WS_CTL = 0, CTL_ZERO_BYTES = 64 * 1024;
constexpr size_t WS_MOD = 1 * MiB;
constexpr size_t WS_WT_MLIN = 2 * MiB;
constexpr size_t WS_WT_MLOUT = 9 * MiB;
constexpr size_t WS_WT_SCIN = 11 * MiB;
constexpr size_t WS_WT_SCOUT = 17 * MiB;
constexpr size_t WS_WT_PL = 19 * MiB;
constexpr size_t WS_WT_FT = 20 * MiB;
constexpr size_t WS_WC = 22 * MiB;
constexpr size_t WS_T256 = 22 * MiB + 256 * 1024;
constexpr size_t WS_T1024 = 22 * MiB + 512 * 1024;
constexpr size_t WS_WT_W1 = 27 * MiB;
constexpr size_t WS_WT_W2 = 59 * MiB;
constexpr size_t WS_H = 91 * MiB;
constexpr size_t WS_HS = 107 * MiB;
constexpr size_t WS_Y = 123 * MiB;
constexpr size_t WS_QKVO = 187 * MiB;
constexpr size_t WS_H1 = 235 * MiB;
constexpr size_t WS_GATES = 299 * MiB;
constexpr size_t WS_L = 300 * MiB;
constexpr size_t WS_NL = 364 * MiB;
constexpr size_t WS_NINIT = 364 * MiB + 512 * 1024;
constexpr size_t WS_MLOC = 365 * MiB;
constexpr size_t WS_BLAST = 365 * MiB + 8192;
constexpr size_t WS_MINIT = 365 * MiB + 16384;
constexpr size_t WS_END = 366 * MiB;

constexpr size_t OUT_YS = 0, OUT_NEWC = 8388608, OUT_NEWN = 10485760, OUT_NEWM = 10502144;

DI float bf2f(unsigned short b) { return __uint_as_float((unsigned)b << 16); }
DI unsigned f2bf(float f) { unsigned u = __float_as_uint(f); return (u + 0x7fffu + ((u >> 16) & 1u)) >> 16; }
DI unsigned pk2(float lo, float hi) { return f2bf(lo) | (f2bf(hi) << 16); }
DI float sigmoidf_(float x) { return 1.0f / (1.0f + __expf(-x)); }

namespace pg8 {
constexpr int BM = 256, BK = 64, HALF = 128, HTB = HALF * BK * 2, STAGE_BYTES = 8 * HTB;
__host__ __device__ __forceinline__ int lds_byte(int r, int c) { const int st = (r >> 4) * 2 + (c >> 5), rr = r & 15, cc = c & 31, ob = rr * 64 + cc * 2; return st * 1024 + (ob ^ (((ob >> 9) & 1) << 5)); }
__host__ __device__ __forceinline__ void stage_rc(int b, int& R, int& C) { const int st = b / 1024, sb = b % 1024, swz = sb ^ (((sb >> 9) & 1) << 5); R = (st >> 1) * 16 + swz / 64; C = (st & 1) * 32 + (swz % 64) / 2; }

struct Unit { const char* a; const char* b; int nt, pm, pn, aux; };

template <class Epi, class Sched>
DI void gemm_phase(LAS unsigned char* lds, const int tid, const int lda, const int ldb, const Sched& S, const Epi& E) {
    const int wid = __builtin_amdgcn_readfirstlane(tid >> 6), lane = tid & 63, wr = wid >> 2, wc = wid & 3, fr = lane & 15, fq = lane >> 4;
    unsigned voffA[2], voffB[2];
#pragma unroll
    for (int i = 0; i < 2; ++i) { int R, C; stage_rc(tid * 16 + i * 8192, R, C); voffA[i] = (unsigned)(R * lda + C) * 2u; voffB[i] = (unsigned)(R * ldb + C) * 2u; }
    const size_t kstep = (size_t)(BK * 2);
    const size_t hstepA = (size_t)HALF * lda * 2, hstepB = (size_t)HALF * ldb * 2;
    const unsigned ldsw = (unsigned)wid * 1024u;
    const int aoff = lds_byte(wr * 64 + fr, fq * 8), boff = lds_byte(wc * 32 + fr, fq * 8);
#define PG8_SA(b, h) (((b) * 2 + (h)) * HTB)
#define PG8_SB(b, h) ((4 + (b) * 2 + (h)) * HTB)
#define PG8_STAGE(bufoff, gbase, voff) do { _Pragma("unroll") for (int _i = 0; _i < 2; ++_i) \
        __builtin_amdgcn_global_load_lds((const unsigned*)((const char*)(gbase) + (voff)[_i]), (LAS unsigned*)(lds + (bufoff) + ldsw + _i * 8192), 16, 0, 0); } while (0)
#define PG8_LDA(dst, b, h) do { _Pragma("unroll") for (int m = 0; m < 4; ++m) _Pragma("unroll") for (int k = 0; k < 2; ++k) dst[m][k] = *(const LAS bf16x8*)(lds + PG8_SA(b, h) + aoff + m * 2048 + k * 1024); } while (0)
#define PG8_LDB(dst, b, h) do { _Pragma("unroll") for (int n = 0; n < 2; ++n) _Pragma("unroll") for (int k = 0; k < 2; ++k) dst[n][k] = *(const LAS bf16x8*)(lds + PG8_SB(b, h) + boff + n * 2048 + k * 1024); } while (0)
#define PG8_MMA(ai, bj, At, Bt) do { __builtin_amdgcn_s_setprio(1); _Pragma("unroll") for (int m = 0; m < 4; ++m) _Pragma("unroll") for (int n = 0; n < 2; ++n) _Pragma("unroll") for (int k = 0; k < 2; ++k) \
        acc[ai][bj][m][n] = __builtin_amdgcn_mfma_f32_16x16x32_bf16(Bt[n][k], At[m][k], acc[ai][bj][m][n], 0, 0, 0); __builtin_amdgcn_s_setprio(0); } while (0)
#define PG8_WAIT_V(n) asm volatile("s_waitcnt vmcnt(" #n ")" ::: "memory")
#define PG8_WAIT_L(n) asm volatile("s_waitcnt lgkmcnt(" #n ")" ::: "memory")
#define PG8_BAR __builtin_amdgcn_s_barrier()
#define PG8_SCHED __builtin_amdgcn_sched_barrier(0)
    Unit cur, nxt; int ui = 0;
    if (!S.next(0, cur)) return;
    f32x4 acc[2][2][4][2];
#pragma unroll
    for (int a = 0; a < 2; ++a)
#pragma unroll
        for (int b = 0; b < 2; ++b)
#pragma unroll
            for (int m = 0; m < 4; ++m)
#pragma unroll
                for (int n = 0; n < 2; ++n) acc[a][b][m][n] = (f32x4){0.f, 0.f, 0.f, 0.f};
    bf16x8 At[4][2], B0[2][2], B1[2][2];
    const char* cA = cur.a; const char* cB = cur.b;
    PG8_STAGE(PG8_SB(0, 0), cB, voffB); PG8_STAGE(PG8_SB(0, 1), cB + hstepB, voffB); PG8_STAGE(PG8_SA(0, 0), cA, voffA); PG8_STAGE(PG8_SA(0, 1), cA + hstepA, voffA);
    if (wr == 1) PG8_BAR;
    PG8_WAIT_V(2); PG8_BAR;
    PG8_STAGE(PG8_SB(1, 0), cB + kstep, voffB); PG8_STAGE(PG8_SA(1, 0), cA + kstep, voffA); PG8_STAGE(PG8_SB(1, 1), cB + hstepB + kstep, voffB);
    PG8_WAIT_V(6); PG8_BAR;
    for (;;) {
        const bool has_next = S.next(ui + 1, nxt);
        const char* nA = has_next ? nxt.a : cA; const char* nB = has_next ? nxt.b : cB;
        const int nt = cur.nt;
        for (int t = 0; t < nt; t += 2) {
            const bool last = (t == nt - 2);
            const char* a1 = cA + (size_t)(t + 1) * kstep;
            const char* a2 = last ? nA : cA + (size_t)(t + 2) * kstep; const char* b2 = last ? nB : cB + (size_t)(t + 2) * kstep;
            const char* a3 = a2 + kstep; const char* b3 = b2 + kstep;
            PG8_LDB(B0, 0, 0); PG8_LDB(B1, 0, 1); PG8_SCHED; PG8_LDA(At, 0, 0); PG8_STAGE(PG8_SA(1, 1), a1 + hstepA, voffA);
            PG8_WAIT_V(8); PG8_WAIT_L(0); PG8_BAR; PG8_MMA(0, 0, At, B0); PG8_MMA(0, 1, At, B1); PG8_BAR; PG8_SCHED;
            PG8_LDA(At, 0, 1); PG8_STAGE(PG8_SB(0, 0), b2, voffB); PG8_STAGE(PG8_SB(0, 1), b2 + hstepB, voffB); PG8_STAGE(PG8_SA(0, 0), a2, voffA);
            PG8_WAIT_V(8); PG8_WAIT_L(0); PG8_BAR; PG8_MMA(1, 0, At, B0); PG8_MMA(1, 1, At, B1); PG8_BAR; PG8_SCHED;
            PG8_LDB(B0, 1, 0); PG8_LDB(B1, 1, 1); PG8_SCHED; PG8_LDA(At, 1, 0); PG8_STAGE(PG8_SA(0, 1), a2 + hstepA, voffA);
            PG8_WAIT_V(8); PG8_WAIT_L(0); PG8_BAR; PG8_MMA(0, 0, At, B0); PG8_MMA(0, 1, At, B1); PG8_BAR; PG8_SCHED;
            PG8_LDA(At, 1, 1); PG8_STAGE(PG8_SB(1, 0), b3, voffB); PG8_STAGE(PG8_SB(1, 1), b3 + hstepB, voffB); PG8_STAGE(PG8_SA(1, 0), a3, voffA);
            PG8_WAIT_V(8); PG8_WAIT_L(0); PG8_BAR; PG8_MMA(1, 0, At, B0); PG8_MMA(1, 1, At, B1); PG8_BAR; PG8_SCHED;
        }
        if (wr == 0) PG8_BAR;
        E(acc, cur, wr, wc, fr, fq);
        if (!has_next) break;
#pragma unroll
        for (int a = 0; a < 2; ++a)
#pragma unroll
            for (int b = 0; b < 2; ++b)
#pragma unroll
                for (int m = 0; m < 4; ++m)
#pragma unroll
                    for (int n = 0; n < 2; ++n) acc[a][b][m][n] = (f32x4){0.f, 0.f, 0.f, 0.f};
        cur = nxt; cA = nA; cB = nB; ++ui;
        if (wr == 1) PG8_BAR;
    }
    PG8_WAIT_V(0);
    PG8_BAR;
#undef PG8_SA
#undef PG8_SB
#undef PG8_STAGE
#undef PG8_LDA
#undef PG8_LDB
#undef PG8_MMA
#undef PG8_WAIT_V
#undef PG8_WAIT_L
#undef PG8_BAR
#undef PG8_SCHED
}
}

typedef GAS unsigned gu32;
#define RLX_AGENT __ATOMIC_RELAXED, __HIP_MEMORY_SCOPE_AGENT
#define XB_TMO      128
#define XB_XCNT(j)  (256  + 64 * (j))
#define XB_XSUB(j)  (1280 + 64 * (j))
#define XB_XGEN(j)  (2304 + 64 * (j))
#define XB_TOP      3328
#define XB_TOPGEN   3392
#define XCD_BAR_WORDS 3456
#define XB_SPIN_CAP (1u << 20)
DI unsigned xb_ld(unsigned* p)              { return __hip_atomic_load(p, __ATOMIC_RELAXED, __HIP_MEMORY_SCOPE_AGENT); }
DI unsigned xb_add(unsigned* p, unsigned v) { return __hip_atomic_fetch_add(p, v, __ATOMIC_RELAXED, __HIP_MEMORY_SCOPE_AGENT); }
DI unsigned xb_xcc_id() { return (unsigned)__builtin_amdgcn_s_getreg((3 << 11) | 20) & 0xFu; }
#define XB_SPIN(cond, bar) do { unsigned _sp = 0; while (cond) { __builtin_amdgcn_s_sleep(1); \
    if ((++_sp & 255u) == 0u) { if (xb_ld(&(bar)[XB_TMO])) break; if (_sp > XB_SPIN_CAP) { atomicAdd(&(bar)[XB_TMO], 1u); break; } } } } while (0)
struct XcdBarrier { unsigned* bar; unsigned x; volatile LAS unsigned* st; };
DI XcdBarrier xcd_barrier_post(unsigned* bar, volatile LAS unsigned* st) {
    XcdBarrier b; b.bar = bar; b.x = xb_xcc_id(); b.st = st;
    if (threadIdx.x == 0) (void)xb_add(&bar[XB_XCNT(b.x)], 1u);
    return b;
}
DI void xcd_barrier_complete(unsigned* bar, unsigned x, unsigned& nloc, unsigned& nx) {
    const unsigned G = gridDim.x * gridDim.y * gridDim.z;
    unsigned sum, cnt, mine, sp = 0u;
    for (;;) {
        sum = 0u; cnt = 0u; mine = 0u;
#pragma unroll
        for (unsigned j = 0; j < 16; ++j) { const unsigned c = xb_ld(&bar[XB_XCNT(j)]); sum += c; cnt += (c > 0u) ? 1u : 0u; mine = (j == x) ? c : mine; }
        if (sum == G) break;
        __builtin_amdgcn_s_sleep(1);
        if ((++sp & 255u) == 0u) { if (xb_ld(&bar[XB_TMO])) break; if (sp > XB_SPIN_CAP) { atomicAdd(&bar[XB_TMO], 1u); break; } }
    }
    nloc = mine > 0u ? mine : 1u; nx = cnt > 0u ? cnt : 1u;
}
DI void xcd_barrier(const XcdBarrier& b) {
    asm volatile("s_waitcnt vmcnt(0)" ::: "memory");
    __syncthreads();
    if (threadIdx.x == 0) {
        unsigned* bar = b.bar;
        __builtin_amdgcn_s_waitcnt(0);
        unsigned nloc = b.st[0], nx = b.st[1];
        if (nloc == 0u) { xcd_barrier_complete(bar, b.x, nloc, nx); b.st[0] = nloc; b.st[1] = nx; }
        const unsigned old = xb_add(&bar[XB_XSUB(b.x)], 1u);
        const unsigned gen = old / nloc;
        if (old + 1u == (gen + 1u) * nloc) {
            __builtin_amdgcn_fence(__ATOMIC_RELEASE, "agent");
            asm volatile("s_waitcnt vmcnt(0)" ::: "memory");
            const unsigned og = xb_add(&bar[XB_TOP], 1u);
            const unsigned tg = og / nx;
            if (og + 1u == (tg + 1u) * nx) xb_add(&bar[XB_TOPGEN], 1u);
            else XB_SPIN(xb_ld(&bar[XB_TOPGEN]) == tg, bar);
            __builtin_amdgcn_fence(__ATOMIC_ACQUIRE, "agent");
            xb_add(&bar[XB_XGEN(b.x)], 1u);
            asm volatile("s_waitcnt vmcnt(0)" ::: "memory");
        } else {
            XB_SPIN(xb_ld(&bar[XB_XGEN(b.x)]) == gen, bar);
            __builtin_amdgcn_fence(__ATOMIC_ACQUIRE, "agent");
            asm volatile("s_waitcnt vmcnt(0)" ::: "memory");
        }
    }
    __syncthreads();
}

struct Args { const float* in[26]; float* out; unsigned char* ws; int ph_lo, ph_hi; };

struct Frame {
    LAS unsigned char* lds;
    int tid, lane, wave, G, bid;
    const float* const* in;
    float* out; unsigned char* ws;
};

DI int row_cond(int row) { return row < NCTX ? 0 : 1 + ((row - NCTX) >> 10); }

enum { K_STD = 0, K_SPLIT2, K_POOL, K_F1, K_F2C, K_F2L };
enum { E_ML = 0, E_BF16, E_RELU2, E_F32SPLIT, E_POOL, E_F1, E_F2 };

template <int SKIND> struct Sched {
    int G, c, n_units, nN, nt;
    const bf16_t* A; const bf16_t* Bt; int lda, ldb;
    DI static void std_tile(int L, int nM, int nN, int& pm, int& pn) {
        const int nwg = nM * nN; int wgid = L;
        { const int q = nwg / 8, r = nwg % 8, xcd = wgid % 8, off = wgid / 8; wgid = (xcd < r ? xcd * (q + 1) : r * (q + 1) + (xcd - r) * q) + off; }
        const int nig = 8 * nN, gid = wgid / nig, fm = gid * 8, gsz = (nM - fm) < 8 ? (nM - fm) : 8;
        pm = fm + ((wgid % nig) % gsz); pn = (wgid % nig) / gsz;
    }
    DI bool next(int i, pg8::Unit& u) const {
        const int L = i * G + c; if (L >= n_units) return false;
        int pm = 0, pn = 0; u.aux = 0; u.nt = nt;
        if constexpr (SKIND == K_STD) { std_tile(L, 32, nN, pm, pn);
            u.a = (const char*)(A + (size_t)pm * 256 * lda); u.b = (const char*)(Bt + (size_t)pn * 256 * ldb); }
        else if constexpr (SKIND == K_SPLIT2) { const int ks = L >> 7; std_tile(L & 127, 32, 4, pm, pn);
            u.a = (const char*)(A + (size_t)pm * 256 * lda + (size_t)ks * nt * 64); u.b = (const char*)(Bt + (size_t)pn * 256 * ldb + (size_t)ks * nt * 64); u.aux = ks; }
        else if constexpr (SKIND == K_POOL) { const int g = L & 3; pm = L >> 2; pn = g;
            u.a = (const char*)(A + (size_t)pm * 256 * lda + g * 256); u.b = (const char*)(Bt + (size_t)g * 65536); }
        else if constexpr (SKIND == K_F1) { const int tt = L >> 3, r = L & 7, g = r >> 1, part = r & 1; pm = part; pn = tt; u.aux = g;
            u.a = (const char*)(A + (size_t)part * 256 * 256); u.b = (const char*)(Bt + (size_t)tt * 256 * ldb + g * 256); }
        else if constexpr (SKIND == K_F2C) { const int b = L >> 2; pn = L & 3; pm = b; u.aux = 0;
            u.a = (const char*)A; u.b = (const char*)(Bt + (size_t)b * (1024 * 512) + (size_t)pn * 256 * 512); }
        else { const int b = L >> 4, pml = (L >> 2) & 3; pn = L & 3; pm = 16 + b * 4 + pml; u.aux = 1;
            u.a = (const char*)(A + (size_t)pml * 256 * 2048); u.b = (const char*)(Bt + (size_t)b * (1024 * 2048) + (size_t)pn * 256 * 2048); }
        u.pm = pm; u.pn = pn; return true;
    }
};

template <int EKIND> struct Epi {
    bf16_t* ob; float* of; int ldc;
    const float* p0; const float* p1;
    template <int KIND> DI void store4(const pg8::Unit& u, int row, int col, f32x4 v) const {
        if (KIND == E_ML) {
            if (col < 3072) {
                if (col >= 512 && col < 1024) v = v * 0.125f;
                u32x2 w; w.x = pk2(v[0], v[1]); w.y = pk2(v[2], v[3]);
                *(u32x2*)(ob + (size_t)row * 3072 + col) = w;
            } else {
                const int cc = col - 3072;
                if (cc < 32) {
                    f32x4 g = v + *(const f32x4*)(p0 + cc);
                    if ((cc >> 3) & 1) {
#pragma unroll
                        for (int j = 0; j < 4; ++j) { const float x = g[j]; g[j] = fminf(x, 0.f) - log1pf(expf(-fabsf(x))); }
                    }
                    *(f32x4*)(of + (size_t)row * 32 + cc) = g;
                }
            }
        } else if (KIND == E_BF16) {
            u32x2 w; w.x = pk2(v[0], v[1]); w.y = pk2(v[2], v[3]);
            *(u32x2*)(ob + (size_t)row * ldc + col) = w;
        } else if (KIND == E_RELU2) {
#pragma unroll
            for (int j = 0; j < 4; ++j) { const float r = fmaxf(v[j], 0.f); v[j] = r * r; }
            u32x2 w; w.x = pk2(v[0], v[1]); w.y = pk2(v[2], v[3]);
            *(u32x2*)(ob + (size_t)row * ldc + col) = w;
        } else if (KIND == E_F32SPLIT) {
            *(f32x4*)(of + (size_t)u.aux * ((size_t)MTOK * D) + (size_t)row * D + col) = v;
        } else if (KIND == E_POOL) {
            const f32x4 b = *(const f32x4*)(p0 + col), s = *(const f32x4*)(p1 + col);
            *(f32x4*)(of + (size_t)row * D + col) = (v + b) * s;
        } else if (KIND == E_F1) {
            const int part = row >> 8, cp = row & 255, n = u.aux * 256 + cp;
            size_t dst;
            if (col < NCTX) { const int b = col >> 8, s = col & 255; dst = (size_t)b * (1024 * 512) + (size_t)n * 512 + part * 256 + s; }
            else { const int t = col - NCTX, b = t >> 10, s = t & 1023; dst = (size_t)16 * (1024 * 512) + (size_t)b * (1024 * 2048) + (size_t)n * 2048 + part * 1024 + s; }
            u32x2 w; w.x = pk2(v[0], v[1]); w.y = pk2(v[2], v[3]);
            *(u32x2*)(ob + dst) = w;
        } else {
            const float sc = u.aux ? (1.0f / 512.0f) : (1.0f / 256.0f);
            v = v * sc;
            u32x2 w; w.x = pk2(v[0], v[1]); w.y = pk2(v[2], v[3]);
            *(u32x2*)(ob + (size_t)row * D + col) = w;
        }
    }
    template <int KIND> DI void run(const f32x4 (&acc)[2][2][4][2], const pg8::Unit& u, int wr, int wc, int fr, int fq) const {
        const int row0 = u.pm * 256 + wr * 64 + fr, col0 = u.pn * 256 + wc * 32 + 4 * fq;
#pragma unroll
        for (int ai = 0; ai < 2; ++ai)
#pragma unroll
            for (int m = 0; m < 4; ++m)
#pragma unroll
                for (int bj = 0; bj < 2; ++bj)
#pragma unroll
                    for (int n = 0; n < 2; ++n) store4<KIND>(u, row0 + ai * 128 + m * 16, col0 + bj * 128 + n * 16, acc[ai][bj][m][n]);
    }
    DI void operator()(const f32x4 (&acc)[2][2][4][2], const pg8::Unit& u, int wr, int wc, int fr, int fq) const { run<EKIND>(acc, u, wr, wc, fr, fq); }
};

#ifdef NAIVE_GEMM
template <int SKIND, int EKIND> DI void gemm_run(Frame& F, const Sched<SKIND>& S, const Epi<EKIND>& E) {
    pg8::Unit u;
    for (int i = 0; S.next(i, u); ++i) {
        const bf16_t* A = (const bf16_t*)u.a; const bf16_t* B = (const bf16_t*)u.b; const int K = u.nt * 64;
        for (int e = F.tid; e < 256 * 64; e += NTHR) {
            const int r = e >> 6, c4 = (e & 63) * 4;
            f32x4 acc = (f32x4){0.f, 0.f, 0.f, 0.f};
            for (int k = 0; k < K; ++k) { const float a = bf2f(A[(size_t)r * S.lda + k]);
#pragma unroll
                for (int j = 0; j < 4; ++j) acc[j] += a * bf2f(B[(size_t)(c4 + j) * S.ldb + k]); }
            E.template store4<EKIND>(u, u.pm * 256 + r, u.pn * 256 + c4, acc);
        }
    }
}
#else
template <int SKIND, int EKIND> DI void gemm_run(Frame& F, const Sched<SKIND>& S, const Epi<EKIND>& E) { pg8::gemm_phase<Epi<EKIND>, Sched<SKIND>>(F.lds, F.tid, S.lda, S.ldb, S, E); }
#endif

DI float wave_sum(float v) {
#pragma unroll
    for (int o = 1; o < 64; o <<= 1) v += __shfl_xor(v, o);
    return v;
}
DI float wave_max(float v) {
#pragma unroll
    for (int o = 1; o < 64; o <<= 1) v = fmaxf(v, __shfl_xor(v, o));
    return v;
}
DI void p0_transpose_item(const float* W, int K, int N, bf16_t* WT, int row_off, LAS float* scr, int item, int lane) {
    const int nblk = N / 32, kb = item / nblk, nb = item % nblk, k0 = 64 * kb, n0 = 32 * nb;
#pragma unroll 8
    for (int i = 0; i < 32; ++i) { const int kk = 2 * i + (lane >> 5); scr[kk * 33 + (lane & 31)] = W[(size_t)(k0 + kk) * N + n0 + (lane & 31)]; }
    asm volatile("s_waitcnt lgkmcnt(0)" ::: "memory");
    const int c = lane & 7;
#pragma unroll
    for (int j = 0; j < 4; ++j) { const int n = (lane >> 3) + 8 * j; const LAS float* s = scr + (8 * c) * 33 + n;
        u32x4 o; o.x = pk2(s[0 * 33], s[1 * 33]); o.y = pk2(s[2 * 33], s[3 * 33]); o.z = pk2(s[4 * 33], s[5 * 33]); o.w = pk2(s[6 * 33], s[7 * 33]);
        *(u32x4*)(WT + (size_t)(row_off + n0 + n) * K + k0 + 8 * c) = o; }
    asm volatile("s_waitcnt lgkmcnt(0)" ::: "memory");
}

DI void phase_prologue_a(Frame& F) {
    const float* const* in = F.in;
    {
        LAS float* sl = (LAS float*)(F.lds + 71680);
        LAS f32x4* red = (LAS f32x4*)(F.lds + 92160);
        for (int e = F.tid; e < NCOND * D; e += NTHR) { const int cd = e >> 10, k = e & 1023; const float c = cd == 0 ? in[6][k] : in[5][(cd - 1) * D + k]; sl[e] = c / (1.0f + expf(-c)); }
        __syncthreads();
        float* MOD = (float*)(F.ws + WS_MOD);
        for (int item = F.bid; item < 256; item += F.G) {
            const int colg = item * 96, l = colg / NMOD, n0 = colg % NMOD;
            const int cg = F.tid % 24, kg = F.tid / 24;
            f32x4 acc[NCOND];
#pragma unroll
            for (int c = 0; c < NCOND; ++c) acc[c] = (f32x4){0.f, 0.f, 0.f, 0.f};
            if (kg < 21) {
                const float* wp = in[7] + (size_t)l * D * NMOD + n0 + cg * 4;
#pragma unroll 7
                for (int k = kg; k < D; k += 21) { const f32x4 w = *(const f32x4*)(wp + (size_t)k * NMOD);
#pragma unroll
                    for (int c = 0; c < NCOND; ++c) acc[c] += w * sl[c * D + k]; }
#pragma unroll
                for (int c = 0; c < NCOND; ++c) red[(kg * NCOND + c) * 24 + cg] = acc[c];
            }
            __syncthreads();
            if (F.tid < NCOND * 24) { const int c = F.tid / 24, g = F.tid % 24; f32x4 s = *(const f32x4*)(in[8] + (size_t)l * NMOD + n0 + g * 4);
                for (int q = 0; q < 21; ++q) s += red[(q * NCOND + c) * 24 + g];
                *(f32x4*)(MOD + ((size_t)l * NCOND + c) * NMOD + n0 + g * 4) = s; }
            __syncthreads();
        }
    }
    __syncthreads();
    {
        LAS float* scr = (LAS float*)(F.lds + F.wave * 8704);
        const int gw = F.bid * NWAVES + F.wave, NGW = F.G * NWAVES;
        bf16_t* wt_mlin = (bf16_t*)(F.ws + WS_WT_MLIN);
        for (int it = gw; it < 21136; it += NGW) {
            int r = it;
            if (r < 1536) { p0_transpose_item(in[13], 1024, 3072, wt_mlin, 0, scr, r, F.lane); continue; } r -= 1536;
            if (r < 16)   { p0_transpose_item(in[14], 1024, 32, wt_mlin, 3072, scr, r, F.lane); continue; } r -= 16;
            if (r < 512)  { p0_transpose_item(in[17], 1024, 1024, (bf16_t*)(F.ws + WS_WT_MLOUT), 0, scr, r, F.lane); continue; } r -= 512;
            if (r < 1536) { p0_transpose_item(in[18], 1024, 3072, (bf16_t*)(F.ws + WS_WT_SCIN), 0, scr, r, F.lane); continue; } r -= 1536;
            if (r < 512)  { p0_transpose_item(in[20], 1024, 1024, (bf16_t*)(F.ws + WS_WT_SCOUT), 0, scr, r, F.lane); continue; } r -= 512;
            if (r < 512)  { p0_transpose_item(in[24], 1024, 1024, (bf16_t*)(F.ws + WS_WT_FT), 0, scr, r, F.lane); continue; } r -= 512;
            if (r < 128)  { const int g = r >> 5; p0_transpose_item(in[21] + (size_t)g * 65536, 256, 256, (bf16_t*)(F.ws + WS_WT_PL) + (size_t)g * 65536, 0, scr, r & 31, F.lane); continue; } r -= 128;
            if (r < 8192) { const int l = r >> 11; p0_transpose_item(in[11] + (size_t)l * D * FF, 1024, 4096, (bf16_t*)(F.ws + WS_WT_W1) + (size_t)l * D * FF, 0, scr, r & 2047, F.lane); continue; } r -= 8192;
            { const int l = r >> 11; p0_transpose_item(in[12] + (size_t)l * D * FF, 4096, 1024, (bf16_t*)(F.ws + WS_WT_W2) + (size_t)l * D * FF, 0, scr, r & 2047, F.lane); }
        }
        const int gt = F.bid * NTHR + F.tid, NGT = F.G * NTHR;
        u32x4* z = (u32x4*)(wt_mlin + (size_t)3104 * 1024);
        for (int i = gt; i < 224 * 1024 / 8; i += NGT) z[i] = (u32x4){0u, 0u, 0u, 0u};
        bf16_t* WC = (bf16_t*)(F.ws + WS_WC); bf16_t* T256 = (bf16_t*)(F.ws + WS_T256); bf16_t* T1024 = (bf16_t*)(F.ws + WS_T1024);
        for (int i = gt; i < 512 * 256; i += NGT) {
            { const int row = i >> 8, k = i & 255, part = row >> 8, c = row & 255; const int r = (c * k) & 255; float sn, cs; sincospif((float)r * (2.0f / 256.0f), &sn, &cs); WC[i] = (bf16_t)f2bf(part ? sn : cs); }
            { const int sp = i >> 9, col = i & 511, part = col >> 8, s = col & 255; const int r = (sp * s) & 255; float sn, cs; sincospif((float)r * (2.0f / 256.0f), &sn, &cs); T256[i] = (bf16_t)f2bf(part ? -sn : cs); }
        }
        for (int i = gt; i < 1024 * 2048; i += NGT) { const int sp = i >> 11, col = i & 2047, part = col >> 10, s = col & 1023; const int r = (sp * s) & 1023; float sn, cs; sincospif((float)r * (2.0f / 1024.0f), &sn, &cs); T1024[i] = (bf16_t)f2bf(part ? -sn : cs); }
    }
}

DI void phase_prologue_b(Frame& F) {
    const int gw = F.bid * NWAVES + F.wave, NGW = F.G * NWAVES;
    const float* MOD = (const float*)(F.ws + WS_MOD);
    bf16_t* H = (bf16_t*)(F.ws + WS_H);
    for (int row = gw; row < MTOK; row += NGW) {
        const int cd = row_cond(row);
        const float* src = row < NCTX ? F.in[0] + (size_t)row * D : F.in[1] + (size_t)(row - NCTX) * D;
        const float* md = MOD + (size_t)cd * NMOD;
        int gr = 0, gc = 0; if (row >= NCTX) { const int t = (row - NCTX) & 1023; gr = t >> 6; gc = t & 63; }
#pragma unroll
        for (int j = 0; j < 4; ++j) {
            const int col = 4 * F.lane + 256 * j;
            f32x4 v = *(const f32x4*)(src + col);
            if (row >= NCTX) {
                const int quarter = j;
#pragma unroll
                for (int e = 0; e < 4; ++e) { const int jj = (col + e) & 255; const float omega = expf(-(float)jj * (9.210340371976184f / 256.0f));
                    const float arg = (float)(quarter < 2 ? gr : gc) * omega; v[e] += (quarter & 1) ? cosf(arg) : sinf(arg); }
            }
            *(f32x4*)(F.out + (size_t)row * D + col) = v;
            const f32x4 sh = *(const f32x4*)(md + col), sc = *(const f32x4*)(md + D + col);
            const f32x4 h = v * (sc + 1.0f) + sh;
            u32x2 w; w.x = pk2(h[0], h[1]); w.y = pk2(h[2], h[3]);
            *(u32x2*)(H + (size_t)row * D + col) = w;
        }
    }
}

DI void phase_ln(Frame& F, int l, int sub, int nsplit, const float* bias) {
    const int gw = F.bid * NWAVES + F.wave, NGW = F.G * NWAVES;
    const float* MOD = (const float*)(F.ws + WS_MOD);
    const float* Y = (const float*)(F.ws + WS_Y);
    bf16_t* H = (bf16_t*)(F.ws + WS_H);
    const float* lg = F.in[9] + (size_t)(l * 2 + sub) * D; const float* lb = F.in[10] + (size_t)(l * 2 + sub) * D;
    const int goff = sub == 0 ? 2 * D : 5 * D;
    const bool has_next = !(l == 3 && sub == 1);
    const int nl = sub == 0 ? l : l + 1, shoff = sub == 0 ? 3 * D : 0, scoff = sub == 0 ? 4 * D : D;
    for (int row = gw; row < MTOK; row += NGW) {
        const int cd = row_cond(row);
        const float* md = MOD + ((size_t)l * NCOND + cd) * NMOD;
        f32x4 v[4]; float s = 0.f;
#pragma unroll
        for (int j = 0; j < 4; ++j) {
            const int col = 4 * F.lane + 256 * j;
            f32x4 y = *(const f32x4*)(Y + (size_t)row * D + col);
            if (nsplit > 1) y += *(const f32x4*)(Y + (size_t)MTOK * D + (size_t)row * D + col);
            if (bias) y += *(const f32x4*)(bias + col);
            const f32x4 x = *(const f32x4*)(F.out + (size_t)row * D + col);
            const f32x4 g = *(const f32x4*)(md + goff + col);
            v[j] = x * ALPHA + g * y;
            s += (v[j][0] + v[j][1]) + (v[j][2] + v[j][3]);
        }
        const float mean = wave_sum(s) * (1.f / D); float s2 = 0.f;
#pragma unroll
        for (int j = 0; j < 4; ++j) { v[j] = v[j] - mean; s2 += (v[j][0] * v[j][0] + v[j][1] * v[j][1]) + (v[j][2] * v[j][2] + v[j][3] * v[j][3]); }
        const float rstd = 1.f / sqrtf(wave_sum(s2) * (1.f / D) + LN_EPS);
        const float* mdn = MOD + ((size_t)(has_next ? nl : 0) * NCOND + cd) * NMOD;
#pragma unroll
        for (int j = 0; j < 4; ++j) {
            const int col = 4 * F.lane + 256 * j;
            const f32x4 xn = v[j] * rstd * *(const f32x4*)(lg + col) + *(const f32x4*)(lb + col);
            *(f32x4*)(F.out + (size_t)row * D + col) = xn;
            if (has_next) {
                const f32x4 sh = *(const f32x4*)(mdn + shoff + col), sc = *(const f32x4*)(mdn + scoff + col);
                const f32x4 h = xn * (sc + 1.0f) + sh;
                u32x2 w; w.x = pk2(h[0], h[1]); w.y = pk2(h[2], h[3]);
                *(u32x2*)(H + (size_t)row * D + col) = w;
            }
        }
    }
}

DI void phase_s1(Frame& F) {
    LAS float* kf = (LAS float*)F.lds;
    LAS float* vf = kf + 64 * 65;
    LAS float* wv = vf + 64 * 128;
    LAS float* gl = wv + 128;
    LAS float* red = gl + 256;
    const bf16_t* QKVO = (const bf16_t*)(F.ws + WS_QKVO);
    const float* GATES = (const float*)(F.ws + WS_GATES);
    float* L = (float*)(F.ws + WS_L); float* NL = (float*)(F.ws + WS_NL); float* MLOC = (float*)(F.ws + WS_MLOC); float* BLAST = (float*)(F.ws + WS_BLAST);
    const int tid = F.tid;
    for (int item = F.bid; item < 1024; item += F.G) {
        const int gb = item >> 3, h = item & 7, row0 = gb * 64;
        __syncthreads();
        { const int j = tid >> 3, c8 = (tid & 7) * 8;
          const u32x4 kk = *(const u32x4*)(QKVO + (size_t)(row0 + j) * 3072 + 512 + h * 64 + c8);
#pragma unroll
          for (int e = 0; e < 4; ++e) { kf[j * 65 + c8 + 2 * e] = __uint_as_float(kk[e] << 16); kf[j * 65 + c8 + 2 * e + 1] = __uint_as_float(kk[e] & 0xffff0000u); }
          const int c16 = (tid & 7) * 16;
#pragma unroll
          for (int q = 0; q < 2; ++q) { const u32x4 vv = *(const u32x4*)(QKVO + (size_t)(row0 + j) * 3072 + 1024 + h * 128 + c16 + q * 8);
#pragma unroll
              for (int e = 0; e < 4; ++e) { vf[j * 128 + c16 + q * 8 + 2 * e] = __uint_as_float(vv[e] << 16); vf[j * 128 + c16 + q * 8 + 2 * e + 1] = __uint_as_float(vv[e] & 0xffff0000u); } }
          if (tid < 256) { const int d = tid >> 7, io = (tid >> 6) & 1, jj = tid & 63; gl[(io * 2 + d) * 64 + jj] = GATES[(size_t)(row0 + jj) * 32 + d * 16 + io * 8 + h]; } }
        __syncthreads();
        if (tid < 128) {
            const int d = tid >> 6, j = tid & 63; const LAS float* lf = gl + (2 + d) * 64;
            float e = 0.f, tot = 0.f;
            for (int u = 0; u < 64; ++u) { const float f = lf[u]; tot += f; if (d == 0 ? (u > j) : (u < j)) e += f; }
            const float a = e + gl[d * 64 + j];
            const float mloc = wave_max(a);
            wv[d * 64 + j] = expf(a - mloc);
            if (j == 0) { red[d] = mloc; red[2 + d] = tot; }
        }
        __syncthreads();
        const int dq = tid >> 3, vg = tid & 7;
        f32x4 a0[4], a1[4]; float n0 = 0.f, n1 = 0.f;
#pragma unroll
        for (int q = 0; q < 4; ++q) { a0[q] = (f32x4){0.f, 0.f, 0.f, 0.f}; a1[q] = (f32x4){0.f, 0.f, 0.f, 0.f}; }
        for (int j = 0; j < 64; ++j) {
            const float kk = kf[j * 65 + dq]; const float w0 = wv[j] * kk, w1 = wv[64 + j] * kk; n0 += w0; n1 += w1;
#pragma unroll
            for (int q = 0; q < 4; ++q) { const f32x4 vv = *(const LAS f32x4*)(vf + j * 128 + vg * 16 + q * 4); a0[q] += vv * w0; a1[q] += vv * w1; }
        }
        const size_t idx0 = (size_t)(gb * 8 + h) * 2;
#pragma unroll
        for (int q = 0; q < 4; ++q) { *(f32x4*)(L + idx0 * 8192 + dq * 128 + vg * 16 + q * 4) = a0[q]; *(f32x4*)(L + (idx0 + 1) * 8192 + dq * 128 + vg * 16 + q * 4) = a1[q]; }
        if (vg == 0) { NL[idx0 * 64 + dq] = n0; NL[(idx0 + 1) * 64 + dq] = n1; }
        if (tid < 2) { MLOC[idx0 + tid] = red[tid]; BLAST[idx0 + tid] = red[2 + tid]; }
    }
}

template <int NC> DI void s2_item(Frame& F, int seq, int h, int d, int slab, int gb0) {
    const float* __restrict__ L = (const float*)(F.ws + WS_L); const float* __restrict__ NL = (const float*)(F.ws + WS_NL);
    const float* __restrict__ MLOC = (const float*)(F.ws + WS_MLOC); const float* __restrict__ BLAST = (const float*)(F.ws + WS_BLAST);
    float* __restrict__ CINIT = (float*)(F.ws + WS_H1); float* __restrict__ NINIT = (float*)(F.ws + WS_NINIT); float* __restrict__ MINIT = (float*)(F.ws + WS_MINIT);
    const int tid = F.tid, e4 = (slab * 512 + tid) * 4;
    const bool nthread = (slab == 0 && tid < 64);
    f32x4 C = (f32x4){0.f, 0.f, 0.f, 0.f}; float n = 0.f, m = 0.f;
    if (seq >= 16) { const size_t base = (size_t)((seq - 16) * 2 + d) * 8 + h; C = *(const f32x4*)(F.in[2] + base * 8192 + e4); if (nthread) n = F.in[3][base * 64 + tid]; m = F.in[4][base]; }
    f32x4 Lv[NC]; float nl[NC], f1[NC], f2[NC], mi[NC];
#pragma unroll
    for (int c = 0; c < NC; ++c) {
        const int gb = d == 0 ? gb0 + c : gb0 + NC - 1 - c; const size_t idx = (size_t)(gb * 8 + h) * 2 + d;
        Lv[c] = *(const f32x4*)(L + idx * 8192 + e4); nl[c] = nthread ? NL[idx * 64 + tid] : 0.f;
        const float bl = BLAST[idx], ml = MLOC[idx], mn = fmaxf(bl + m, ml);
        mi[c] = m; f1[c] = expf(bl + m - mn); f2[c] = expf(ml - mn); m = mn;
    }
#pragma unroll
    for (int c = 0; c < NC; ++c) {
        const int gb = d == 0 ? gb0 + c : gb0 + NC - 1 - c; const size_t idx = (size_t)(gb * 8 + h) * 2 + d;
        *(f32x4*)(CINIT + idx * 8192 + e4) = C;
        if (nthread) NINIT[idx * 64 + tid] = n;
        if (slab == 0 && tid == 0) MINIT[idx] = mi[c];
        C = C * f1[c] + Lv[c] * f2[c]; n = n * f1[c] + nl[c] * f2[c];
    }
    if (seq < 16) { const size_t ob = (size_t)(seq * 2 + d) * 8 + h; *(f32x4*)(F.out + OUT_NEWC + ob * 8192 + e4) = C; if (nthread) F.out[OUT_NEWN + ob * 64 + tid] = n; if (slab == 0 && tid == 0) F.out[OUT_NEWM + ob] = m; }
}
DI void phase_s2(Frame& F) {
    for (int item = F.bid; item < 1280; item += F.G) {
        const int st = item >> 2, slab = item & 3, seq = st >> 4, h = (st >> 1) & 7, d = st & 1;
        if (seq < 16) s2_item<4>(F, seq, h, d, slab, seq * 4);
        else s2_item<16>(F, seq, h, d, slab, 64 + (seq - 16) * 16);
    }
}

DI void phase_s3(Frame& F) {
    LAS float* qf = (LAS float*)F.lds;
    LAS float* kf = qf + 64 * 65;
    LAS float* vf = kf + 64 * 65;
    LAS float* Cf = vf + 64 * 128;
    LAS float* Cb = Cf + 64 * 128;
    LAS float* gl = Cb + 64 * 128;
    LAS float* cum = gl + 256;
    LAS float* suf = cum + 64;
    LAS float* nfb = suf + 64;
    const bf16_t* QKVO = (const bf16_t*)(F.ws + WS_QKVO);
    const float* GATES = (const float*)(F.ws + WS_GATES);
    const float* CINIT = (const float*)(F.ws + WS_H1); const float* NINIT = (const float*)(F.ws + WS_NINIT); const float* MINIT = (const float*)(F.ws + WS_MINIT);
    bf16_t* HS = (bf16_t*)(F.ws + WS_HS);
    const float* norm_g = F.in[16];
    const int tid = F.tid;
    for (int item = F.bid; item < 1024; item += F.G) {
        const int gb = item >> 3, h = item & 7, row0 = gb * 64;
        const size_t idx0 = (size_t)(gb * 8 + h) * 2;
        __syncthreads();
        { const int j = tid >> 3, c8 = (tid & 7) * 8;
          const u32x4 qq = *(const u32x4*)(QKVO + (size_t)(row0 + j) * 3072 + h * 64 + c8);
          const u32x4 kk = *(const u32x4*)(QKVO + (size_t)(row0 + j) * 3072 + 512 + h * 64 + c8);
#pragma unroll
          for (int e = 0; e < 4; ++e) { qf[j * 65 + c8 + 2 * e] = __uint_as_float(qq[e] << 16); qf[j * 65 + c8 + 2 * e + 1] = __uint_as_float(qq[e] & 0xffff0000u);
                                        kf[j * 65 + c8 + 2 * e] = __uint_as_float(kk[e] << 16); kf[j * 65 + c8 + 2 * e + 1] = __uint_as_float(kk[e] & 0xffff0000u); }
          const int c16 = (tid & 7) * 16;
#pragma unroll
          for (int q = 0; q < 2; ++q) { const u32x4 vv = *(const u32x4*)(QKVO + (size_t)(row0 + j) * 3072 + 1024 + h * 128 + c16 + q * 8);
#pragma unroll
              for (int e = 0; e < 4; ++e) { vf[j * 128 + c16 + q * 8 + 2 * e] = __uint_as_float(vv[e] << 16); vf[j * 128 + c16 + q * 8 + 2 * e + 1] = __uint_as_float(vv[e] & 0xffff0000u); } }
          if (tid < 256) { const int d = tid >> 7, io = (tid >> 6) & 1, jj = tid & 63; gl[(io * 2 + d) * 64 + jj] = GATES[(size_t)(row0 + jj) * 32 + d * 16 + io * 8 + h]; }
          if (tid < 128) nfb[tid] = NINIT[(idx0 + (tid >> 6)) * 64 + (tid & 63)];
#pragma unroll
          for (int q = 0; q < 4; ++q) { const int e = tid * 4 + q * 2048; *(LAS f32x4*)(Cf + e) = *(const f32x4*)(CINIT + idx0 * 8192 + e); *(LAS f32x4*)(Cb + e) = *(const f32x4*)(CINIT + (idx0 + 1) * 8192 + e); } }
        const float mf = MINIT[idx0], mb = MINIT[idx0 + 1];
        __syncthreads();
        if (tid < 64) { float s = 0.f; for (int u = 0; u <= tid; ++u) s += gl[2 * 64 + u]; cum[tid] = s; }
        else if (tid < 128) { const int j = tid - 64; float s = 0.f; for (int u = j; u < 64; ++u) s += gl[3 * 64 + u]; suf[j] = s; }
        __syncthreads();
        const int t = tid >> 3, sub = tid & 7;
        float sr[8];
#pragma unroll
        for (int i = 0; i < 8; ++i) sr[i] = 0.f;
        float qnf = 0.f, qnb = 0.f;
        for (int dd = 0; dd < 64; ++dd) { const float qv = qf[t * 65 + dd];
#pragma unroll
            for (int i = 0; i < 8; ++i) sr[i] += qv * kf[(sub * 8 + i) * 65 + dd]; }
#pragma unroll
        for (int i = 0; i < 8; ++i) { const float qv = qf[t * 65 + sub * 8 + i]; qnf += qv * nfb[sub * 8 + i]; qnb += qv * nfb[64 + sub * 8 + i]; }
        qnf += __shfl_xor(qnf, 1); qnf += __shfl_xor(qnf, 2); qnf += __shfl_xor(qnf, 4);
        qnb += __shfl_xor(qnb, 1); qnb += __shfl_xor(qnb, 2); qnb += __shfl_xor(qnb, 4);
        const float ct = cum[t], stt = suf[t];
        float df[8], db[8]; float mxf = ct + mf, mxb = stt + mb;
#pragma unroll
        for (int i = 0; i < 8; ++i) { const int s = sub * 8 + i;
            df[i] = (s <= t) ? (ct - cum[s] + gl[s]) : -INFINITY; db[i] = (s >= t) ? (stt - suf[s] + gl[64 + s]) : -INFINITY;
            mxf = fmaxf(mxf, df[i]); mxb = fmaxf(mxb, db[i]); }
        mxf = fmaxf(mxf, __shfl_xor(mxf, 1)); mxf = fmaxf(mxf, __shfl_xor(mxf, 2)); mxf = fmaxf(mxf, __shfl_xor(mxf, 4));
        mxb = fmaxf(mxb, __shfl_xor(mxb, 1)); mxb = fmaxf(mxb, __shfl_xor(mxb, 2)); mxb = fmaxf(mxb, __shfl_xor(mxb, 4));
        float pf[8], pb[8], sumf = 0.f, sumb = 0.f;
#pragma unroll
        for (int i = 0; i < 8; ++i) { const int s = sub * 8 + i;
            pf[i] = (s <= t) ? sr[i] * expf(df[i] - mxf) : 0.f; pb[i] = (s >= t) ? sr[i] * expf(db[i] - mxb) : 0.f; sumf += pf[i]; sumb += pb[i]; }
        sumf += __shfl_xor(sumf, 1); sumf += __shfl_xor(sumf, 2); sumf += __shfl_xor(sumf, 4);
        sumb += __shfl_xor(sumb, 1); sumb += __shfl_xor(sumb, 2); sumb += __shfl_xor(sumb, 4);
        const float af = expf(ct + mf - mxf), ab = expf(stt + mb - mxb);
        const float rf = 1.0f / fmaxf(fabsf(sumf + af * qnf), expf(-mxf)), rb = 1.0f / fmaxf(fabsf(sumb + ab * qnb), expf(-mxb));
        const float cf = af * rf, cb = ab * rb;
        __syncthreads();
        LAS float* Pm = kf;
#pragma unroll
        for (int i = 0; i < 8; ++i) Pm[t * 65 + sub * 8 + i] = pf[i] * rf + pb[i] * rb;
        __syncthreads();
        const int vg = sub;
        f32x4 acc[4];
#pragma unroll
        for (int q = 0; q < 4; ++q) acc[q] = (f32x4){0.f, 0.f, 0.f, 0.f};
        for (int s = 0; s < 64; ++s) { const float p = Pm[t * 65 + s];
#pragma unroll
            for (int q = 0; q < 4; ++q) acc[q] += *(const LAS f32x4*)(vf + s * 128 + vg * 16 + q * 4) * p; }
        for (int dd = 0; dd < 64; ++dd) { const float qv = qf[t * 65 + dd]; const float a = qv * cf, b = qv * cb;
#pragma unroll
            for (int q = 0; q < 4; ++q) acc[q] += *(const LAS f32x4*)(Cf + dd * 128 + vg * 16 + q * 4) * a + *(const LAS f32x4*)(Cb + dd * 128 + vg * 16 + q * 4) * b; }
        float sm = 0.f;
#pragma unroll
        for (int q = 0; q < 4; ++q) sm += (acc[q][0] + acc[q][1]) + (acc[q][2] + acc[q][3]);
        sm += __shfl_xor(sm, 1); sm += __shfl_xor(sm, 2); sm += __shfl_xor(sm, 4);
        const float mu = sm * (1.0f / 128.0f); float vs = 0.f;
#pragma unroll
        for (int q = 0; q < 4; ++q) { acc[q] = acc[q] - mu; vs += (acc[q][0] * acc[q][0] + acc[q][1] * acc[q][1]) + (acc[q][2] * acc[q][2] + acc[q][3] * acc[q][3]); }
        vs += __shfl_xor(vs, 1); vs += __shfl_xor(vs, 2); vs += __shfl_xor(vs, 4);
        const float rstd = 1.0f / sqrtf(vs * (1.0f / 128.0f) + LN_EPS);
        const size_t orow = (size_t)(row0 + t);
#pragma unroll
        for (int q2 = 0; q2 < 2; ++q2) {
            const u32x4 ov = *(const u32x4*)(QKVO + orow * 3072 + 2048 + h * 128 + vg * 16 + q2 * 8);
            u32x4 w;
#pragma unroll
            for (int e = 0; e < 4; ++e) {
                const int q = q2 * 2 + (e >> 1), i0 = (e & 1) * 2;
                const float g0 = norm_g[h * 128 + vg * 16 + q * 4 + i0], g1 = norm_g[h * 128 + vg * 16 + q * 4 + i0 + 1];
                const float o0 = __uint_as_float(ov[e] << 16), o1 = __uint_as_float(ov[e] & 0xffff0000u);
                w[e] = pk2(acc[q][i0] * rstd * g0 * sigmoidf_(o0), acc[q][i0 + 1] * rstd * g1 * sigmoidf_(o1));
            }
            *(u32x4*)(HS + orow * D + h * 128 + vg * 16 + q2 * 8) = w;
        }
    }
}

DI void phase_conv(Frame& F) {
    const bf16_t* __restrict__ BCU = (const bf16_t*)(F.ws + WS_QKVO); bf16_t* __restrict__ HS = (bf16_t*)(F.ws + WS_HS);
    const float* __restrict__ cw = F.in[19];
    const int gt = F.bid * NTHR + F.tid, NGT = F.G * NTHR;
    constexpr int UNR = 4;
    for (int i0 = gt; i0 < MTOK * 128; i0 += UNR * NGT) {
        u32x4 cg[UNR][3], uu[UNR][3], bg[UNR]; float wgt[UNR][3];
#pragma unroll
        for (int q = 0; q < UNR; ++q) {
            int i = i0 + q * NGT; if (i >= MTOK * 128) i = MTOK * 128 - 1;
            const int row = i >> 7, c8 = (i & 127) * 8;
            const int s = row < NCTX ? (row & 255) : ((row - NCTX) & 1023), S = row < NCTX ? 256 : 1024;
#pragma unroll
            for (int j = 0; j < 3; ++j) { const int ss = s + j - 1; const bool ok = ss >= 0 && ss < S; const size_t r2 = (size_t)(ok ? row + j - 1 : row);
                wgt[q][j] = ok ? 1.f : 0.f; cg[q][j] = *(const u32x4*)(BCU + r2 * 3072 + 1024 + c8); uu[q][j] = *(const u32x4*)(BCU + r2 * 3072 + 2048 + c8); }
            bg[q] = *(const u32x4*)(BCU + (size_t)row * 3072 + c8);
        }
#pragma unroll
        for (int q = 0; q < UNR; ++q) {
            const int i = i0 + q * NGT; if (i >= MTOK * 128) break;
            const int row = i >> 7, c8 = (i & 127) * 8;
            float accv[8];
#pragma unroll
            for (int e = 0; e < 8; ++e) accv[e] = 0.f;
#pragma unroll
            for (int j = 0; j < 3; ++j) {
                const f32x4 w0 = *(const f32x4*)(cw + j * D + c8) * wgt[q][j], w1 = *(const f32x4*)(cw + j * D + c8 + 4) * wgt[q][j];
#pragma unroll
                for (int e = 0; e < 4; ++e) {
                    const float wl = e < 2 ? w0[2 * e] : w1[2 * e - 4], wh = e < 2 ? w0[2 * e + 1] : w1[2 * e - 3];
                    accv[2 * e] += wl * (__uint_as_float(cg[q][j][e] << 16) * __uint_as_float(uu[q][j][e] << 16));
                    accv[2 * e + 1] += wh * (__uint_as_float(cg[q][j][e] & 0xffff0000u) * __uint_as_float(uu[q][j][e] & 0xffff0000u));
                }
            }
            u32x4 w;
#pragma unroll
            for (int e = 0; e < 4; ++e) w[e] = pk2(__uint_as_float(bg[q][e] << 16) * accv[2 * e], __uint_as_float(bg[q][e] & 0xffff0000u) * accv[2 * e + 1]);
            *(u32x4*)(HS + (size_t)row * D + c8) = w;
        }
    }
}

template <int WIN> DI void poolprep_item(Frame& F, int row, int c4) {
    const float* __restrict__ MOD = (const float*)(F.ws + WS_MOD); bf16_t* __restrict__ HS = (bf16_t*)(F.ws + WS_HS);
    const float* __restrict__ X = F.out;
    const int cd = row_cond(row);
    const int s = row < NCTX ? (row & 255) : ((row - NCTX) & 1023), S = row < NCTX ? 256 : 1024;
    const float* md = MOD + ((size_t)2 * NCOND + cd) * NMOD;
    const f32x4 sh = *(const f32x4*)(md + c4), sc = *(const f32x4*)(md + D + c4) + 1.0f;
    f32x4 xv[WIN]; float wg[WIN];
#pragma unroll
    for (int j = 0; j < WIN; ++j) { const int ss = s + j - WIN / 2; const bool ok = ss >= 0 && ss < S; wg[j] = ok ? 1.f : 0.f; xv[j] = *(const f32x4*)(X + (size_t)(ok ? row + j - WIN / 2 : row) * D + c4); }
    f32x4 sum = (f32x4){0.f, 0.f, 0.f, 0.f}; float cnt = 0.f;
#pragma unroll
    for (int j = 0; j < WIN; ++j) { sum += xv[j] * wg[j]; cnt += wg[j]; }
    const f32x4 p = (sum * (1.0f / cnt) - xv[WIN / 2]) * sc;
    u32x2 w; w.x = pk2(p[0], p[1]); w.y = pk2(p[2], p[3]);
    *(u32x2*)(HS + (size_t)row * D + c4) = w;
}
DI void phase_poolprep(Frame& F) {
    const int gt = F.bid * NTHR + F.tid, NGT = F.G * NTHR;
    for (int i = gt; i < MTOK * 256; i += NGT) {
        const int row = i >> 8, c4 = (i & 255) * 4, g = (i & 255) >> 6;
        if (g == 0) poolprep_item<2>(F, row, c4); else if (g == 1) poolprep_item<4>(F, row, c4); else if (g == 2) poolprep_item<8>(F, row, c4); else poolprep_item<16>(F, row, c4);
    }
}

constexpr int NPHASE = 31;
enum { PK_PRO_A = 0, PK_PRO_B, PK_LN0, PK_UP, PK_DOWN, PK_LN1, PK_ML_IN, PK_S1, PK_S2, PK_S3, PK_OUTPROJ, PK_SC_IN, PK_CONV, PK_POOLPREP, PK_POOLGEMM, PK_F1, PK_F2, PK_COUNT };
template <int SKIND> DI Sched<SKIND> make_sched(Frame& F, const bf16_t* A, int lda, const bf16_t* Bt, int ldb, int n_units, int nN, int nt, int rot) {
    Sched<SKIND> S; S.G = F.G; S.c = (F.bid + rot) % F.G; S.n_units = n_units; S.nN = nN; S.nt = nt; S.A = A; S.Bt = Bt; S.lda = lda; S.ldb = ldb; return S;
}
template <int EKIND> DI Epi<EKIND> make_epi(bf16_t* ob, float* of, int ldc, const float* p0, const float* p1) { Epi<EKIND> E; E.ob = ob; E.of = of; E.ldc = ldc; E.p0 = p0; E.p1 = p1; return E; }

template <int PK> DI void run_kind(Frame& F, int layer) {
    unsigned char* ws = F.ws;
    const bf16_t* H = (const bf16_t*)(ws + WS_H); const bf16_t* HS = (const bf16_t*)(ws + WS_HS);
    if constexpr (PK == PK_PRO_A) phase_prologue_a(F);
    else if constexpr (PK == PK_PRO_B) phase_prologue_b(F);
    else if constexpr (PK == PK_LN0) phase_ln(F, layer, 0, layer == 2 ? 1 : 2, layer == 3 ? F.in[25] : nullptr);
    else if constexpr (PK == PK_LN1) phase_ln(F, layer, 1, 2, nullptr);
    else if constexpr (PK == PK_UP) { auto S = make_sched<K_STD>(F, H, D, (const bf16_t*)(ws + WS_WT_W1) + (size_t)layer * D * FF, D, 512, 16, 16, 0);
        auto E = make_epi<E_RELU2>((bf16_t*)(ws + WS_H1), nullptr, FF, nullptr, nullptr); gemm_run(F, S, E); }
    else if constexpr (PK == PK_DOWN) { auto S = make_sched<K_SPLIT2>(F, (const bf16_t*)(ws + WS_H1), FF, (const bf16_t*)(ws + WS_WT_W2) + (size_t)layer * D * FF, FF, 256, 4, 32, 0);
        auto E = make_epi<E_F32SPLIT>(nullptr, (float*)(ws + WS_Y), 0, nullptr, nullptr); gemm_run(F, S, E); }
    else if constexpr (PK == PK_ML_IN) { auto S = make_sched<K_STD>(F, H, D, (const bf16_t*)(ws + WS_WT_MLIN), D, 32 * 13, 13, 16, 0);
        auto E = make_epi<E_ML>((bf16_t*)(ws + WS_QKVO), (float*)(ws + WS_GATES), 0, F.in[15], nullptr); gemm_run(F, S, E); }
    else if constexpr (PK == PK_S1) phase_s1(F);
    else if constexpr (PK == PK_S2) phase_s2(F);
    else if constexpr (PK == PK_S3) phase_s3(F);
    else if constexpr (PK == PK_OUTPROJ) { const size_t wo = layer == 0 ? WS_WT_MLOUT : (layer == 1 ? WS_WT_SCOUT : WS_WT_FT);
        auto S = make_sched<K_SPLIT2>(F, HS, D, (const bf16_t*)(ws + wo), D, 256, 4, 8, 0);
        auto E = make_epi<E_F32SPLIT>(nullptr, (float*)(ws + WS_Y), 0, nullptr, nullptr); gemm_run(F, S, E); }
    else if constexpr (PK == PK_SC_IN) { auto S = make_sched<K_STD>(F, H, D, (const bf16_t*)(ws + WS_WT_SCIN), D, 32 * 12, 12, 16, 0);
        auto E = make_epi<E_BF16>((bf16_t*)(ws + WS_QKVO), nullptr, 3072, nullptr, nullptr); gemm_run(F, S, E); }
    else if constexpr (PK == PK_CONV) phase_conv(F);
    else if constexpr (PK == PK_POOLPREP) phase_poolprep(F);
    else if constexpr (PK == PK_POOLGEMM) { auto S = make_sched<K_POOL>(F, HS, D, (const bf16_t*)(ws + WS_WT_PL), 256, 128, 4, 4, 0);
        auto E = make_epi<E_POOL>(nullptr, (float*)(ws + WS_Y), 0, F.in[22], F.in[23]); gemm_run(F, S, E); }
    else if constexpr (PK == PK_F1) { auto S = make_sched<K_F1>(F, (const bf16_t*)(ws + WS_WC), 256, H, D, 256, 32, 4, 0);
        auto E = make_epi<E_F1>((bf16_t*)(ws + WS_QKVO), nullptr, 0, nullptr, nullptr); gemm_run(F, S, E); }
    else { auto E = make_epi<E_F2>((bf16_t*)(ws + WS_HS), nullptr, 0, nullptr, nullptr);
        { auto S = make_sched<K_F2L>(F, (const bf16_t*)(ws + WS_T1024), 2048, (const bf16_t*)(ws + WS_QKVO) + (size_t)16 * 1024 * 512, 2048, 64, 4, 32, 0); gemm_run(F, S, E); }
        __syncthreads();
        { auto S = make_sched<K_F2C>(F, (const bf16_t*)(ws + WS_T256), 512, (const bf16_t*)(ws + WS_QKVO), 512, 64, 4, 8, (F.G > 64 ? F.G - 64 : 0)); gemm_run(F, S, E); } }
}

__host__ __device__ inline void phase_of(int ph, int& pk, int& layer) {
    layer = 0;
    if (ph >= 7 && ph <= 10) { layer = 0; pk = PK_LN0 + (ph - 7); return; }
    if (ph >= 14 && ph <= 17) { layer = 1; pk = PK_LN0 + (ph - 14); return; }
    if (ph >= 20 && ph <= 23) { layer = 2; pk = PK_LN0 + (ph - 20); return; }
    if (ph >= 27 && ph <= 30) { layer = 3; pk = PK_LN0 + (ph - 27); return; }
    switch (ph) {
    case 0: pk = PK_PRO_A; break; case 1: pk = PK_PRO_B; break; case 2: pk = PK_ML_IN; break; case 3: pk = PK_S1; break; case 4: pk = PK_S2; break; case 5: pk = PK_S3; break;
    case 6: layer = 0; pk = PK_OUTPROJ; break; case 11: pk = PK_SC_IN; break; case 12: pk = PK_CONV; break; case 13: layer = 1; pk = PK_OUTPROJ; break;
    case 18: pk = PK_POOLPREP; break; case 19: pk = PK_POOLGEMM; break; case 24: pk = PK_F1; break; case 25: pk = PK_F2; break; default: layer = 3; pk = PK_OUTPROJ; break;
    }
}

DI void frame_init(Frame& F, const Args& args, unsigned char* lds_raw) {
    F.lds = (LAS unsigned char*)lds_raw;
    F.tid = threadIdx.x; F.lane = F.tid & 63; F.wave = __builtin_amdgcn_readfirstlane(F.tid >> 6);
    F.G = gridDim.x; F.bid = blockIdx.x;
    F.in = (const float* const*)__builtin_amdgcn_kernarg_segment_ptr();
    F.out = args.out; F.ws = args.ws;
}

DI void frame_launder(Frame& F, const Args& args, unsigned char* lds_raw) {
    size_t z = 0; int p_tid = threadIdx.x, p_bid = blockIdx.x, p_g = gridDim.x;
    asm volatile("" : "+s"(z), "+v"(p_tid), "+s"(p_bid), "+s"(p_g));
    F.in = (const float* const*)((const char*)__builtin_amdgcn_kernarg_segment_ptr() + z); F.out = (float*)((char*)args.out + z); F.ws = args.ws + z;
    F.tid = p_tid; F.lane = p_tid & 63; F.wave = __builtin_amdgcn_readfirstlane(p_tid >> 6); F.bid = p_bid; F.G = p_g;
    F.lds = (LAS unsigned char*)lds_raw + (unsigned)z;
}
__global__ void __launch_bounds__(NTHR, 2) mega_fwd(Args args) {
    extern __shared__ __attribute__((aligned(16))) unsigned char lds_raw[];
    Frame F; frame_init(F, args, lds_raw);
    volatile LAS unsigned* MISC = (volatile LAS unsigned*)(F.lds + LDS_BYTES - 64);
    if (F.tid < 16) MISC[F.tid] = 0u;
    __syncthreads();
    (void)xcd_barrier_post((unsigned*)(args.ws + WS_CTL) + 1024, MISC);
#ifndef DBL_MASK
#define DBL_MASK 0u
#endif
#define PHASE(PK, layer) do { frame_launder(F, args, lds_raw); run_kind<PK>(F, (layer)); \
        if ((DBL_MASK >> (PK)) & 1u) { SEAM(); frame_launder(F, args, lds_raw); run_kind<PK>(F, (layer)); } } while (0)
#define SEAM() do { frame_launder(F, args, lds_raw); XcdBarrier b_; b_.bar = (unsigned*)(F.ws + WS_CTL) + 1024; b_.x = xb_xcc_id(); b_.st = (volatile LAS unsigned*)(F.lds + LDS_BYTES - 64); xcd_barrier(b_); } while (0)
    PHASE(PK_PRO_A, 0); SEAM();
    PHASE(PK_PRO_B, 0); SEAM();
#define MLP_TAIL(l, last) do { PHASE(PK_LN0, l); SEAM(); PHASE(PK_UP, l); SEAM(); PHASE(PK_DOWN, l); SEAM(); PHASE(PK_LN1, l); if (!(last)) SEAM(); } while (0)
    PHASE(PK_ML_IN, 0); SEAM(); PHASE(PK_S1, 0); SEAM(); PHASE(PK_S2, 0); SEAM(); PHASE(PK_S3, 0); SEAM(); PHASE(PK_OUTPROJ, 0); SEAM();
    MLP_TAIL(0, false);
    PHASE(PK_SC_IN, 1); SEAM(); PHASE(PK_CONV, 1); SEAM(); PHASE(PK_OUTPROJ, 1); SEAM();
    MLP_TAIL(1, false);
    PHASE(PK_POOLPREP, 2); SEAM(); PHASE(PK_POOLGEMM, 2); SEAM();
    MLP_TAIL(2, false);
    PHASE(PK_F1, 3); SEAM(); PHASE(PK_F2, 3); SEAM(); PHASE(PK_OUTPROJ, 3); SEAM();
    MLP_TAIL(3, true);
#undef MLP_TAIL
#undef PHASE
#undef SEAM
}

template <int PK> __global__ void __launch_bounds__(NTHR, 2) phase_kernel(Args args) {
    extern __shared__ __attribute__((aligned(16))) unsigned char lds_raw[];
    Frame F; frame_init(F, args, lds_raw);
    run_kind<PK>(F, args.ph_lo);
}

template <int PK> static void launch_phase(int grid, const Args& a, hipStream_t stream, bool setattr) {
    if (setattr) { (void)hipFuncSetAttribute((const void*)phase_kernel<PK>, hipFuncAttributeMaxDynamicSharedMemorySize, LDS_BYTES); return; }
    hipLaunchKernelGGL(phase_kernel<PK>, dim3(grid), dim3(NTHR), LDS_BYTES, stream, a);
}
static void launch_kind(int pk, int grid, const Args& a, hipStream_t stream, bool setattr) {
    switch (pk) {
    case PK_PRO_A: launch_phase<PK_PRO_A>(grid, a, stream, setattr); break;
    case PK_PRO_B: launch_phase<PK_PRO_B>(grid, a, stream, setattr); break;
    case PK_LN0: launch_phase<PK_LN0>(grid, a, stream, setattr); break;
    case PK_UP: launch_phase<PK_UP>(grid, a, stream, setattr); break;
    case PK_DOWN: launch_phase<PK_DOWN>(grid, a, stream, setattr); break;
    case PK_LN1: launch_phase<PK_LN1>(grid, a, stream, setattr); break;
    case PK_ML_IN: launch_phase<PK_ML_IN>(grid, a, stream, setattr); break;
    case PK_S1: launch_phase<PK_S1>(grid, a, stream, setattr); break;
    case PK_S2: launch_phase<PK_S2>(grid, a, stream, setattr); break;
    case PK_S3: launch_phase<PK_S3>(grid, a, stream, setattr); break;
    case PK_OUTPROJ: launch_phase<PK_OUTPROJ>(grid, a, stream, setattr); break;
    case PK_SC_IN: launch_phase<PK_SC_IN>(grid, a, stream, setattr); break;
    case PK_CONV: launch_phase<PK_CONV>(grid, a, stream, setattr); break;
    case PK_POOLPREP: launch_phase<PK_POOLPREP>(grid, a, stream, setattr); break;
    case PK_POOLGEMM: launch_phase<PK_POOLGEMM>(grid, a, stream, setattr); break;
    case PK_F1: launch_phase<PK_F1>(grid, a, stream, setattr); break;
    default: launch_phase<PK_F2>(grid, a, stream, setattr); break;
    }
}

extern "C" void kernel_launch(void* const* d_in, const int* in_sizes, int n_in, void* d_out, int out_size, void* d_ws, size_t ws_size, hipStream_t stream) {
    static int grid = 0;
    Args a{};
    if (grid == 0) {
        if (n_in != 26 || out_size != 10502400 || ws_size < WS_END) { fprintf(stderr, "kernel_launch: unexpected shapes (n_in %d out %d ws %zu)\n", n_in, out_size, ws_size); grid = -1; return; }
        int dev = 0, cus = 0;
        if (hipGetDevice(&dev) != hipSuccess || hipDeviceGetAttribute(&cus, hipDeviceAttributeMultiprocessorCount, dev) != hipSuccess) { grid = -1; return; }
#if MK_ONE_LAUNCH
        int per_cu = 0;
        if (hipFuncSetAttribute((const void*)mega_fwd, hipFuncAttributeMaxDynamicSharedMemorySize, LDS_BYTES) != hipSuccess) { fprintf(stderr, "kernel_launch: hipFuncSetAttribute failed\n"); grid = -1; return; }
        if (hipOccupancyMaxActiveBlocksPerMultiprocessor(&per_cu, (const void*)mega_fwd, NTHR, LDS_BYTES) != hipSuccess || per_cu < 1) { fprintf(stderr, "kernel_launch: occupancy query says %d blocks per CU\n", per_cu); (void)hipGetLastError(); grid = -1; return; }
#else
        for (int pk = 0; pk < PK_COUNT; ++pk) launch_kind(pk, 0, a, stream, true);
        (void)hipGetLastError();
#endif
        grid = cus;
    }
    if (grid < 0) return;
    for (int i = 0; i < 26; ++i) a.in[i] = (const float*)d_in[i];
    a.out = (float*)d_out; a.ws = (unsigned char*)d_ws;
#if MK_ONE_LAUNCH
    (void)hipMemsetAsync((char*)d_ws + WS_CTL, 0, CTL_ZERO_BYTES, stream);
    a.ph_lo = 0; a.ph_hi = NPHASE;
    void* kargs[] = {&a};
    hipError_t e = hipLaunchCooperativeKernel((const void*)mega_fwd, dim3(grid), dim3(NTHR), kargs, LDS_BYTES, stream);
    if (e != hipSuccess) fprintf(stderr, "kernel_launch: cooperative launch failed: %s (grid %d)\n", hipGetErrorString(e), grid);
#else
    for (int ph = 0; ph < NPHASE; ++ph) {
        int pk, layer; phase_of(ph, pk, layer);
        a.ph_lo = layer; a.ph_hi = 0;
        launch_kind(pk, grid, a, stream, false);
    }
#endif
}
```

```cpp
#include <hip/hip_runtime.h>
#include <cstdio>
#include <cstdint>


#define LAS __attribute__((address_space(3)))
#define GAS __attribute__((address_space(1)))
typedef unsigned short bf16_t;
typedef short bf16x8 __attribute__((ext_vector_type(8)));
typedef float f32x4 __attribute__((ext_vector_type(4)));
typedef float f32x2 __attribute__((ext_vector_type(2)));
typedef unsigned u32x4 __attribute__((ext_vector_type(4)));
typedef unsigned u32x2 __attribute__((ext_vector_type(2)));
#define DI __device__ __forceinline__

constexpr int D = 1024, MTOK = 8192, NCTX = 4096, FF = 4096, NHEAD = 8, DQK = 64, DHV = 128;
constexpr int MLN = 3328;
constexpr int NCOND = 5, NMOD = 6 * D;
constexpr float ALPHA = 1.6817928305074292f;
constexpr float LN_EPS = 1e-5f;
constexpr int NWAVES = 8, NTHR = 512;
constexpr int LDS_BYTES = 147456;

constexpr size_t MiB = 1u << 20;
constexpr size_t WS_CTL = 0, CTL_ZERO_BYTES = 256 * 1024;
constexpr int CW_TMO = 0, CW_BAR = 1024, CW_FLAGS = 8192, CW_CNT = 24576;
constexpr size_t WS_POS = 1 * MiB + 768 * 1024;
constexpr size_t WS_XS = 1 * MiB + 512 * 1024;
constexpr size_t WS_MOD = 1 * MiB;
constexpr size_t WS_WT_MLIN = 2 * MiB;
constexpr size_t WS_WT_MLOUT = 9 * MiB;
constexpr size_t WS_WT_SCIN = 11 * MiB;
constexpr size_t WS_WT_SCOUT = 17 * MiB;
constexpr size_t WS_WT_PL = 19 * MiB;
constexpr size_t WS_WT_FT = 20 * MiB;
constexpr size_t WS_WC = 22 * MiB;
constexpr size_t WS_T256 = 22 * MiB + 256 * 1024;
constexpr size_t WS_T1024 = 22 * MiB + 512 * 1024;
constexpr size_t WS_WT_W1 = 27 * MiB;
constexpr size_t WS_WT_W2 = 59 * MiB;
constexpr size_t WS_H = 91 * MiB;
constexpr size_t WS_HS = 107 * MiB;
constexpr size_t WS_Y = 123 * MiB;
constexpr size_t WS_X16 = 140 * MiB;
constexpr size_t WS_QKVO = 187 * MiB;
constexpr size_t WS_H1 = 235 * MiB;
constexpr size_t WS_GATES = 299 * MiB;
constexpr size_t WS_L = 300 * MiB;
constexpr size_t WS_NL = 364 * MiB;
constexpr size_t WS_NINIT = 364 * MiB + 512 * 1024;
constexpr size_t WS_MLOC = 365 * MiB;
constexpr size_t WS_BLAST = 365 * MiB + 8192;
constexpr size_t WS_MINIT = 365 * MiB + 16384;
constexpr size_t WS_END = 366 * MiB;

constexpr size_t OUT_YS = 0, OUT_NEWC = 8388608, OUT_NEWN = 10485760, OUT_NEWM = 10502144;

DI float bf2f(unsigned short b) { return __uint_as_float((unsigned)b << 16); }
DI unsigned f2bf(float f) { unsigned u = __float_as_uint(f); return (u + 0x7fffu + ((u >> 16) & 1u)) >> 16; }
typedef __bf16 bf16x2_t __attribute__((ext_vector_type(2)));
DI unsigned pk2(float lo, float hi) { const f32x2 v = {lo, hi}; const bf16x2_t b = __builtin_convertvector(v, bf16x2_t); return __builtin_bit_cast(unsigned, b); }
DI float sigmoidf_(float x) { return __builtin_amdgcn_rcpf(1.0f + __expf(-x)); }
DI float log_sigmoidf_(float x) { const float e = __expf(-fabsf(x)); const float l = e < 1.0e-4f ? e * (1.0f - 0.5f * e) : __logf(1.0f + e); return fminf(x, 0.f) - l; }

namespace pg8 {
constexpr int BM = 256, BK = 64, HALF = 128, HTB = HALF * BK * 2, STAGE_BYTES = 8 * HTB;
__host__ __device__ __forceinline__ int lds_byte(int r, int c) { const int st = (r >> 4) * 2 + (c >> 5), rr = r & 15, cc = c & 31, ob = rr * 64 + cc * 2; return st * 1024 + (ob ^ (((ob >> 9) & 1) << 5)); }
__host__ __device__ __forceinline__ void stage_rc(int b, int& R, int& C) { const int st = b / 1024, sb = b % 1024, swz = sb ^ (((sb >> 9) & 1) << 5); R = (st >> 1) * 16 + swz / 64; C = (st & 1) * 32 + (swz % 64) / 2; }

__host__ __device__ __forceinline__ int perm32(int rho) { const int n = rho >> 4, i = rho & 15; return 8 * (i >> 2) + 4 * n + (i & 3); }
struct Unit { const char* a; const char* b; int nt, pm, pn, aux; };

template <class Epi, class Sched>
DI void gemm_phase(LAS unsigned char* lds, const int tid, const int lda, const int ldb, const Sched& S, const Epi& E) {
    const int wid = __builtin_amdgcn_readfirstlane(tid >> 6), lane = tid & 63, wr = wid >> 2, wc = wid & 3, fr = lane & 15, fq = lane >> 4;
    unsigned voffA[2], voffB[2];
#pragma unroll
    for (int i = 0; i < 2; ++i) { int R, C; stage_rc(tid * 16 + i * 8192, R, C); const int Rb = Epi::PERM ? ((R & ~31) + perm32(R & 31)) : R;
        voffA[i] = (unsigned)(R * lda + C) * 2u; voffB[i] = (unsigned)(Rb * ldb + C) * 2u; }
    const size_t kstep = (size_t)(BK * 2);
    const size_t hstepA = (size_t)HALF * lda * 2, hstepB = (size_t)HALF * ldb * 2;
    const unsigned ldsw = (unsigned)wid * 1024u;
    const int aoff = lds_byte(wr * 64 + fr, fq * 8), boff = lds_byte(wc * 32 + fr, fq * 8);
#define PG8_SA(b, h) (((b) * 2 + (h)) * HTB)
#define PG8_SB(b, h) ((4 + (b) * 2 + (h)) * HTB)
#define PG8_STAGE(bufoff, gbase, voff) do { _Pragma("unroll") for (int _i = 0; _i < 2; ++_i) \
        __builtin_amdgcn_global_load_lds((const unsigned*)((const char*)(gbase) + (voff)[_i]), (LAS unsigned*)(lds + (bufoff) + ldsw + _i * 8192), 16, 0, 0); } while (0)
#define PG8_LDA(dst, b, h) do { _Pragma("unroll") for (int m = 0; m < 4; ++m) _Pragma("unroll") for (int k = 0; k < 2; ++k) dst[m][k] = *(const LAS bf16x8*)(lds + PG8_SA(b, h) + aoff + m * 2048 + k * 1024); } while (0)
#define PG8_LDB(dst, b, h) do { _Pragma("unroll") for (int n = 0; n < 2; ++n) _Pragma("unroll") for (int k = 0; k < 2; ++k) dst[n][k] = *(const LAS bf16x8*)(lds + PG8_SB(b, h) + boff + n * 2048 + k * 1024); } while (0)
#define PG8_MMA(ai, bj, At, Bt) do { __builtin_amdgcn_s_setprio(1); _Pragma("unroll") for (int m = 0; m < 4; ++m) _Pragma("unroll") for (int n = 0; n < 2; ++n) _Pragma("unroll") for (int k = 0; k < 2; ++k) \
        acc[ai][bj][m][n] = __builtin_amdgcn_mfma_f32_16x16x32_bf16(Bt[n][k], At[m][k], acc[ai][bj][m][n], 0, 0, 0); __builtin_amdgcn_s_setprio(0); } while (0)
#define PG8_WAIT_V(n) asm volatile("s_waitcnt vmcnt(" #n ")" ::: "memory")
#define PG8_WAIT_L(n) asm volatile("s_waitcnt lgkmcnt(" #n ")" ::: "memory")
#define PG8_BAR __builtin_amdgcn_s_barrier()
#define PG8_SCHED __builtin_amdgcn_sched_barrier(0)
    constexpr bool HN = Sched::HALFN;
    Unit cur, nxt; int ui = 0;
    if (!S.next(0, cur)) return;
    f32x4 acc[2][2][4][2];
#pragma unroll
    for (int a = 0; a < 2; ++a)
#pragma unroll
        for (int b = 0; b < 2; ++b)
#pragma unroll
            for (int m = 0; m < 4; ++m)
#pragma unroll
                for (int n = 0; n < 2; ++n) acc[a][b][m][n] = (f32x4){0.f, 0.f, 0.f, 0.f};
    bf16x8 At[4][2], B0[2][2], B1[2][2];
    const char* cA = cur.a; const char* cB = cur.b;
    PG8_STAGE(PG8_SB(0, 0), cB, voffB); if constexpr (!HN) PG8_STAGE(PG8_SB(0, 1), cB + hstepB, voffB); PG8_STAGE(PG8_SA(0, 0), cA, voffA); PG8_STAGE(PG8_SA(0, 1), cA + hstepA, voffA);
    if (wr == 1) PG8_BAR;
    PG8_WAIT_V(2); PG8_BAR;
    PG8_STAGE(PG8_SB(1, 0), cB + kstep, voffB); PG8_STAGE(PG8_SA(1, 0), cA + kstep, voffA); if constexpr (!HN) PG8_STAGE(PG8_SB(1, 1), cB + hstepB + kstep, voffB);
    if constexpr (HN) PG8_WAIT_V(4); else PG8_WAIT_V(6);
    PG8_BAR;
    for (;;) {
        const bool has_next = S.next(ui + 1, nxt);
        const char* nA = has_next ? nxt.a : cA + (size_t)(cur.nt - 2) * kstep; const char* nB = has_next ? nxt.b : cB + (size_t)(cur.nt - 2) * kstep;
        const int nt = cur.nt;
        for (int t = 0; t < nt; t += 2) {
            const bool last = (t == nt - 2);
            const char* a1 = cA + (size_t)(t + 1) * kstep;
            const char* a2 = last ? nA : cA + (size_t)(t + 2) * kstep; const char* b2 = last ? nB : cB + (size_t)(t + 2) * kstep;
            const char* a3 = a2 + kstep; const char* b3 = b2 + kstep;
            PG8_LDB(B0, 0, 0); if constexpr (!HN) PG8_LDB(B1, 0, 1); PG8_SCHED; PG8_LDA(At, 0, 0); PG8_STAGE(PG8_SA(1, 1), a1 + hstepA, voffA);
            if constexpr (HN) PG8_WAIT_V(6); else PG8_WAIT_V(8);
            PG8_WAIT_L(0); PG8_BAR; PG8_MMA(0, 0, At, B0); if constexpr (!HN) PG8_MMA(0, 1, At, B1); PG8_BAR; PG8_SCHED;
            PG8_LDA(At, 0, 1); PG8_STAGE(PG8_SB(0, 0), b2, voffB); if constexpr (!HN) PG8_STAGE(PG8_SB(0, 1), b2 + hstepB, voffB); PG8_STAGE(PG8_SA(0, 0), a2, voffA);
            if constexpr (HN) PG8_WAIT_V(6); else PG8_WAIT_V(8);
            PG8_WAIT_L(0); PG8_BAR; PG8_MMA(1, 0, At, B0); if constexpr (!HN) PG8_MMA(1, 1, At, B1); PG8_BAR; PG8_SCHED;
            PG8_LDB(B0, 1, 0); if constexpr (!HN) PG8_LDB(B1, 1, 1); PG8_SCHED; PG8_LDA(At, 1, 0); PG8_STAGE(PG8_SA(0, 1), a2 + hstepA, voffA);
            if constexpr (HN) PG8_WAIT_V(6); else PG8_WAIT_V(8);
            PG8_WAIT_L(0); PG8_BAR; PG8_MMA(0, 0, At, B0); if constexpr (!HN) PG8_MMA(0, 1, At, B1); PG8_BAR; PG8_SCHED;
            PG8_LDA(At, 1, 1); PG8_STAGE(PG8_SB(1, 0), b3, voffB); if constexpr (!HN) PG8_STAGE(PG8_SB(1, 1), b3 + hstepB, voffB); PG8_STAGE(PG8_SA(1, 0), a3, voffA);
            if constexpr (HN) PG8_WAIT_V(6); else PG8_WAIT_V(8);
            PG8_WAIT_L(0); PG8_BAR; PG8_MMA(1, 0, At, B0); if constexpr (!HN) PG8_MMA(1, 1, At, B1); PG8_BAR; PG8_SCHED;
        }
        if constexpr (!Epi::AFTER_DRAIN) { if (wr == 0) PG8_BAR;
            if constexpr (HN) E.half(acc, cur, wr, wc, fr, fq); else E(acc, cur, wr, wc, fr, fq); }
        if (!has_next) break;
#pragma unroll
        for (int a = 0; a < 2; ++a)
#pragma unroll
            for (int b = 0; b < 2; ++b)
#pragma unroll
                for (int m = 0; m < 4; ++m)
#pragma unroll
                    for (int n = 0; n < 2; ++n) acc[a][b][m][n] = (f32x4){0.f, 0.f, 0.f, 0.f};
        cur = nxt; cA = nA; cB = nB; ++ui;
        if constexpr (!Epi::AFTER_DRAIN) { if (wr == 1) PG8_BAR; }
    }
    PG8_WAIT_V(0);
    if constexpr (Epi::AFTER_DRAIN) { if (wr == 0) PG8_BAR; }
    PG8_BAR;
    if constexpr (Epi::AFTER_DRAIN) E.fused(acc, cur, wr, wc, fr, fq, lds, wid, lane, tid);
#undef PG8_SA
#undef PG8_SB
#undef PG8_STAGE
#undef PG8_LDA
#undef PG8_LDB
#undef PG8_MMA
#undef PG8_WAIT_V
#undef PG8_WAIT_L
#undef PG8_BAR
#undef PG8_SCHED
}
}

typedef GAS unsigned gu32;
#define RLX_AGENT __ATOMIC_RELAXED, __HIP_MEMORY_SCOPE_AGENT
#define XB_TMO      128
#define XB_XCNT(j)  (256  + 64 * (j))
#define XB_XSUB(j)  (1280 + 64 * (j))
#define XB_XGEN(j)  (2304 + 64 * (j))
#define XB_TOP      3328
#define XB_TOPGEN   3392
#define XCD_BAR_WORDS 3456
#define XB_SPIN_CAP (1u << 20)
DI unsigned xb_ld(unsigned* p)              { return __hip_atomic_load(p, __ATOMIC_RELAXED, __HIP_MEMORY_SCOPE_AGENT); }
DI unsigned xb_add(unsigned* p, unsigned v) { return __hip_atomic_fetch_add(p, v, __ATOMIC_RELAXED, __HIP_MEMORY_SCOPE_AGENT); }
DI unsigned xb_xcc_id() { return (unsigned)__builtin_amdgcn_s_getreg((3 << 11) | 20) & 0xFu; }
#define XB_SPIN(cond, bar) do { unsigned _sp = 0; while (cond) { __builtin_amdgcn_s_sleep(1); \
    if ((++_sp & 255u) == 0u) { if (xb_ld(&(bar)[XB_TMO])) break; if (_sp > XB_SPIN_CAP) { atomicAdd(&(bar)[XB_TMO], 1u); break; } } } } while (0)
struct XcdBarrier { unsigned* bar; unsigned x; volatile LAS unsigned* st; };
DI XcdBarrier xcd_barrier_post(unsigned* bar, volatile LAS unsigned* st) {
    XcdBarrier b; b.bar = bar; b.x = xb_xcc_id(); b.st = st;
    if (threadIdx.x == 0) st[3] = xb_add(&bar[XB_XCNT(b.x)], 1u);
    return b;
}
DI void xcd_barrier_complete(unsigned* bar, unsigned x, unsigned& nloc, unsigned& info) {
    const unsigned G = gridDim.x * gridDim.y * gridDim.z;
    unsigned sum, cnt, mine, mask, sp = 0u;
    for (;;) {
        sum = 0u; cnt = 0u; mine = 0u; mask = 0u;
#pragma unroll
        for (unsigned j = 0; j < 16; ++j) { const unsigned c = xb_ld(&bar[XB_XCNT(j)]); sum += c; cnt += (c > 0u) ? 1u : 0u; mask |= (c > 0u) ? (1u << j) : 0u; mine = (j == x) ? c : mine; }
        if (sum == G) break;
        __builtin_amdgcn_s_sleep(1);
        if ((++sp & 255u) == 0u) { if (xb_ld(&bar[XB_TMO])) break; if (sp > XB_SPIN_CAP) { atomicAdd(&bar[XB_TMO], 1u); break; } }
    }
    nloc = mine > 0u ? mine : 1u; if (cnt == 0u) { cnt = 1u; mask = 1u << x; }
    info = mask | (cnt << 16);
}
DI bool xcd_census_uniform(unsigned* bar) {
    unsigned cnt = 0u; bool ok = true;
#pragma unroll
    for (unsigned j = 0; j < 16; ++j) { const unsigned c = xb_ld(&bar[XB_XCNT(j)]); if (c > 0u) { ++cnt; ok = ok && (c == 32u); } }
    return ok && cnt == 8u;
}
DI void xcd_barrier(const XcdBarrier& b) {
    asm volatile("s_waitcnt vmcnt(0)" ::: "memory");
    __syncthreads();
    if (threadIdx.x == 0) {
        unsigned* bar = b.bar;
        __builtin_amdgcn_s_waitcnt(0);
        unsigned nloc = b.st[0], info = b.st[1];
        if (nloc == 0u) { xcd_barrier_complete(bar, b.x, nloc, info); b.st[0] = nloc; b.st[1] = info;
            b.st[4] = (unsigned)__builtin_popcount(info & ((1u << b.x) - 1u) & 0xffffu); b.st[5] = xcd_census_uniform(bar) ? 1u : 0u; }
        const unsigned k = b.st[2]; b.st[2] = k + 1u;
        const unsigned old = xb_add(&bar[XB_XSUB(b.x)], 1u);
        __builtin_amdgcn_fence(__ATOMIC_ACQUIRE, "agent");
        if (old + 1u == (k + 1u) * nloc) {
            __builtin_amdgcn_fence(__ATOMIC_RELEASE, "agent");
            asm volatile("s_waitcnt vmcnt(0)" ::: "memory");
#pragma unroll
            for (unsigned j = 0; j < 16; ++j) if ((info >> j) & 1u) (void)xb_add(&bar[XB_XGEN(j)], 1u);
        }
        const unsigned target = (k + 1u) * (info >> 16);
        XB_SPIN(xb_ld(&bar[XB_XGEN(b.x)]) < target, bar);
        asm volatile("s_waitcnt vmcnt(0)" ::: "memory");
    }
    __syncthreads();
}

#define XB_XLOC(j)  (3456 + 64 * (j))
DI void xcc_local_barrier(const XcdBarrier& b) {
    asm volatile("s_waitcnt vmcnt(0)" ::: "memory");
    __syncthreads();
    if (threadIdx.x == 0) {
        unsigned* bar = b.bar;
        __builtin_amdgcn_s_waitcnt(0);
        const unsigned kl = b.st[6]; b.st[6] = kl + 1u;
        (void)xb_add(&bar[XB_XLOC(b.x)], 1u);
        __builtin_amdgcn_fence(__ATOMIC_ACQUIRE, "agent");
        const unsigned target = (kl + 1u) * 32u;
        XB_SPIN(xb_ld(&bar[XB_XLOC(b.x)]) < target, bar);
        asm volatile("s_waitcnt vmcnt(0)" ::: "memory");
    }
    __syncthreads();
}

struct Args { const float* in[26]; float* out; unsigned char* ws; int ph_lo, ph_hi; };

struct Frame {
    LAS unsigned char* lds;
    int tid, lane, wave, G, bid;
    int uni, xidx, rank;
    const float* const* in;
    float* out; unsigned char* ws;
};

struct ItemIter { int start, stride, per, base; };
DI ItemIter wg_items(const Frame& F, int N)  { ItemIter it; if (F.uni) { it.start = F.rank; it.stride = 32; it.per = N >> 3; it.base = F.xidx * (N >> 3); } else { it.start = F.bid; it.stride = F.G; it.per = N; it.base = 0; } return it; }
DI ItemIter thr_items(const Frame& F, int N) { ItemIter it; if (F.uni) { it.start = F.rank * NTHR + F.tid; it.stride = 32 * NTHR; it.per = N >> 3; it.base = F.xidx * (N >> 3); } else { it.start = F.bid * NTHR + F.tid; it.stride = F.G * NTHR; it.per = N; it.base = 0; } return it; }
DI ItemIter wave_items(const Frame& F, int N) { ItemIter it; if (F.uni) { it.start = F.rank * NWAVES + F.wave; it.stride = 32 * NWAVES; it.per = N >> 3; it.base = F.xidx * (N >> 3); } else { it.start = F.bid * NWAVES + F.wave; it.stride = F.G * NWAVES; it.per = N; it.base = 0; } return it; }

DI int row_cond(int row) { return row < NCTX ? 0 : 1 + ((row - NCTX) >> 10); }

enum { K_STD = 0, K_SPLIT2, K_POOL, K_F1, K_F2C, K_F2L, K_POOL2, K_UPX, K_SPLITX, K_POOLX, K_STDX };
enum { E_ML = 0, E_BF16, E_RELU2, E_F32SPLIT, E_POOL, E_F1, E_F2, E_NONE, E_SC };

template <int SKIND> struct Sched {
    static constexpr bool HALFN = (SKIND == K_F2L);
    int G, c, n_units, nN, nt; int xidx, rank, uni;
    const bf16_t* A; const bf16_t* Bt; int lda, ldb;
    DI static void std_tile(int L, int nM, int nN, int& pm, int& pn) {
        const int nwg = nM * nN; int wgid = L;
        { const int q = nwg / 8, r = nwg % 8, xcd = wgid % 8, off = wgid / 8; wgid = (xcd < r ? xcd * (q + 1) : r * (q + 1) + (xcd - r) * q) + off; }
        const int nig = 8 * nN, gid = wgid / nig, fm = gid * 8, gsz = (nM - fm) < 8 ? (nM - fm) : 8;
        pm = fm + ((wgid % nig) % gsz); pn = (wgid % nig) / gsz;
    }
    DI bool next(int i, pg8::Unit& u) const {
        int pm = 0, pn = 0; u.aux = 0; u.nt = nt;
        if constexpr (SKIND == K_UPX || SKIND == K_SPLITX || SKIND == K_POOLX || SKIND == K_STDX) {
            if (uni) {
                const int per = (SKIND == K_UPX) ? 64 : (SKIND == K_STDX) ? 4 * nN : 32, Ll = i * 32 + rank; if (Ll >= per) return false;
                if constexpr (SKIND == K_UPX || SKIND == K_STDX) { pm = 4 * xidx + (Ll & 3); pn = Ll >> 2;
                    u.a = (const char*)(A + (size_t)pm * 256 * lda); u.b = (const char*)(Bt + (size_t)pn * 256 * ldb); }
                else { const int ks = Ll & 1; pm = 4 * xidx + ((Ll >> 1) & 3); pn = Ll >> 3; u.aux = ks;
                    if constexpr (SKIND == K_SPLITX) { u.a = (const char*)(A + (size_t)pm * 256 * lda + (size_t)ks * nt * 64); u.b = (const char*)(Bt + (size_t)pn * 256 * ldb + (size_t)ks * nt * 64); }
                    else { u.a = (const char*)(A + (size_t)pm * 256 * lda + pn * 256 + ks * 128); u.b = (const char*)(Bt + (size_t)pn * 65536 + ks * 128); } }
                u.pm = pm; u.pn = pn; return true;
            }
        }
        int L = i * G + c;
        if constexpr (SKIND == K_F1 || SKIND == K_F2C || SKIND == K_F2L) {
            if (uni) {
                if (i > 0) return false;
                if constexpr (SKIND == K_F1) L = xidx * 32 + rank;
                else if constexpr (SKIND == K_F2C) { if (xidx >= 4 || rank >= 16) return false; L = xidx * 16 + rank; }
                else { if (xidx < 4) return false; L = (xidx - 4) * 32 + rank; }
            }
        }
        if (L >= n_units) return false;
        if constexpr (SKIND == K_STD || SKIND == K_UPX || SKIND == K_STDX) { std_tile(L, 32, nN, pm, pn);
            u.a = (const char*)(A + (size_t)pm * 256 * lda); u.b = (const char*)(Bt + (size_t)pn * 256 * ldb); }
        else if constexpr (SKIND == K_SPLIT2 || SKIND == K_SPLITX) {
            const int x = L & 7, j = L >> 3; const int ks = x & 1;
            pm = 8 * (x >> 1) + (j & 7); pn = j >> 3;
            u.a = (const char*)(A + (size_t)pm * 256 * lda + (size_t)ks * nt * 64); u.b = (const char*)(Bt + (size_t)pn * 256 * ldb + (size_t)ks * nt * 64); u.aux = ks; }
        else if constexpr (SKIND == K_POOL) { const int g = L & 3; pm = L >> 2; pn = g;
            u.a = (const char*)(A + (size_t)pm * 256 * lda + g * 256); u.b = (const char*)(Bt + (size_t)g * 65536); }
        else if constexpr (SKIND == K_POOL2 || SKIND == K_POOLX) { const int ks = L >> 7, T = L & 127, g = T & 3; pm = T >> 2; pn = g; u.aux = ks;
            u.a = (const char*)(A + (size_t)pm * 256 * lda + g * 256 + ks * 128); u.b = (const char*)(Bt + (size_t)g * 65536 + ks * 128); }
        else if constexpr (SKIND == K_F1) { const int tt = L >> 3, r = L & 7, g = r >> 1, part = r & 1; pm = part; pn = tt; u.aux = g;
            u.a = (const char*)(A + (size_t)part * 256 * 256); u.b = (const char*)(Bt + (size_t)tt * 256 * ldb + g * 256); }
        else if constexpr (SKIND == K_F2C) { const int b = L >> 2; pn = L & 3; pm = b; u.aux = 0;
            u.a = (const char*)A; u.b = (const char*)(Bt + (size_t)b * (1024 * 512) + (size_t)pn * 256 * 512); }
        else { const int b = L >> 5, pml = (L >> 3) & 3, hf = L & 1; pn = (L >> 1) & 3; pm = 16 + b * 4 + pml; u.aux = 1 | (hf << 1);
            u.a = (const char*)(A + (size_t)pml * 256 * 2048); u.b = (const char*)(Bt + (size_t)b * (1024 * 2048) + (size_t)(pn * 256 + hf * 128) * 2048); }
        u.pm = pm; u.pn = pn; return true;
    }
};

template <int EKIND> struct Epi {
    static constexpr bool AFTER_DRAIN = false;
    static constexpr bool PERM = (EKIND == E_ML || EKIND == E_BF16 || EKIND == E_RELU2 || EKIND == E_F1 || EKIND == E_F2 || EKIND == E_SC);
    template <int KIND> DI void store8(const pg8::Unit& u, int row, int col, f32x4 v0, f32x4 v1) const {
        if (KIND == E_ML) {
            if (col < 3072) {
                if (col >= 512 && col < 1024) { v0 = v0 * 0.125f; v1 = v1 * 0.125f; }
                u32x4 w; w.x = pk2(v0[0], v0[1]); w.y = pk2(v0[2], v0[3]); w.z = pk2(v1[0], v1[1]); w.w = pk2(v1[2], v1[3]);
                *(u32x4*)(ob + (size_t)row * 3072 + col) = w;
            } else {
                const int cc = col - 3072;
                if (cc < 32) {
                    f32x4 g0 = v0 + *(const f32x4*)(p0 + cc), g1 = v1 + *(const f32x4*)(p0 + cc + 4);
                    if ((cc >> 3) & 1) {
#pragma unroll
                        for (int j = 0; j < 4; ++j) { g0[j] = log_sigmoidf_(g0[j]); g1[j] = log_sigmoidf_(g1[j]); }
                    }
                    *(f32x4*)(of + (size_t)row * 32 + cc) = g0; *(f32x4*)(of + (size_t)row * 32 + cc + 4) = g1;
                }
            }
        } else if (KIND == E_BF16) {
            u32x4 w; w.x = pk2(v0[0], v0[1]); w.y = pk2(v0[2], v0[3]); w.z = pk2(v1[0], v1[1]); w.w = pk2(v1[2], v1[3]);
            *(u32x4*)(ob + (size_t)row * ldc + col) = w;
        } else if (KIND == E_RELU2) {
#pragma unroll
            for (int j = 0; j < 4; ++j) { float r0, r1; asm("v_max_f32 %0, 0, %1" : "=v"(r0) : "v"(v0[j])); asm("v_max_f32 %0, 0, %1" : "=v"(r1) : "v"(v1[j])); v0[j] = r0 * r0; v1[j] = r1 * r1; }
            u32x4 w; w.x = pk2(v0[0], v0[1]); w.y = pk2(v0[2], v0[3]); w.z = pk2(v1[0], v1[1]); w.w = pk2(v1[2], v1[3]);
            *(u32x4*)(ob + (size_t)row * ldc + col) = w;
        } else if (KIND == E_F1) {
            const int part = row >> 8, cp = row & 255, n = u.aux * 256 + cp;
            size_t dst;
            if (u.pn < 16) { const int b = col >> 8, s = col & 255; dst = (size_t)b * (1024 * 512) + (size_t)n * 512 + part * 256 + s; }
            else { const int t = col - NCTX, b = t >> 10, s = t & 1023; dst = (size_t)16 * (1024 * 512) + (size_t)b * (1024 * 2048) + (size_t)n * 2048 + part * 1024 + s; }
            u32x4 w; w.x = pk2(v0[0], v0[1]); w.y = pk2(v0[2], v0[3]); w.z = pk2(v1[0], v1[1]); w.w = pk2(v1[2], v1[3]);
            *(u32x4*)(ob + dst) = w;
        } else {
            const float sc = u.aux ? (1.0f / 512.0f) : (1.0f / 256.0f);
            v0 = v0 * sc; v1 = v1 * sc;
            u32x4 w; w.x = pk2(v0[0], v0[1]); w.y = pk2(v0[2], v0[3]); w.z = pk2(v1[0], v1[1]); w.w = pk2(v1[2], v1[3]);
            *(u32x4*)(ob + (size_t)row * D + col) = w;
        }
    }
    bf16_t* ob; float* of; int ldc;
    const float* p0; const float* p1;
    template <int KIND> DI void store4(const pg8::Unit& u, int row, int col, f32x4 v) const {
        if (KIND == E_ML) {
            if (col < 3072) {
                if (col >= 512 && col < 1024) v = v * 0.125f;
                u32x2 w; w.x = pk2(v[0], v[1]); w.y = pk2(v[2], v[3]);
                *(u32x2*)(ob + (size_t)row * 3072 + col) = w;
            } else {
                const int cc = col - 3072;
                if (cc < 32) {
                    f32x4 g = v + *(const f32x4*)(p0 + cc);
                    if ((cc >> 3) & 1) {
#pragma unroll
                        for (int j = 0; j < 4; ++j) g[j] = log_sigmoidf_(g[j]);
                    }
                    *(f32x4*)(of + (size_t)row * 32 + cc) = g;
                }
            }
        } else if (KIND == E_BF16) {
            u32x2 w; w.x = pk2(v[0], v[1]); w.y = pk2(v[2], v[3]);
            *(u32x2*)(ob + (size_t)row * ldc + col) = w;
        } else if (KIND == E_RELU2) {
#pragma unroll
            for (int j = 0; j < 4; ++j) { const float r = fmaxf(v[j], 0.f); v[j] = r * r; }
            u32x2 w; w.x = pk2(v[0], v[1]); w.y = pk2(v[2], v[3]);
            *(u32x2*)(ob + (size_t)row * ldc + col) = w;
        } else if (KIND == E_F32SPLIT) {
            *(f32x4*)(of + (size_t)u.aux * ((size_t)MTOK * D) + (size_t)row * D + col) = v;
        } else if (KIND == E_POOL) {
            const f32x4 b = *(const f32x4*)(p0 + col), s = *(const f32x4*)(p1 + col);
            *(f32x4*)(of + (size_t)row * D + col) = (v + b) * s;
        } else if (KIND == E_NONE) {
            asm volatile("" :: "v"(v));
        } else if (KIND == E_F1) {
            const int part = row >> 8, cp = row & 255, n = u.aux * 256 + cp;
            size_t dst;
            if (u.pn < 16) { const int b = col >> 8, s = col & 255; dst = (size_t)b * (1024 * 512) + (size_t)n * 512 + part * 256 + s; }
            else { const int t = col - NCTX, b = t >> 10, s = t & 1023; dst = (size_t)16 * (1024 * 512) + (size_t)b * (1024 * 2048) + (size_t)n * 2048 + part * 1024 + s; }
            u32x2 w; w.x = pk2(v[0], v[1]); w.y = pk2(v[2], v[3]);
            *(u32x2*)(ob + dst) = w;
        } else {
            const float sc = u.aux ? (1.0f / 512.0f) : (1.0f / 256.0f);
            v = v * sc;
            u32x2 w; w.x = pk2(v[0], v[1]); w.y = pk2(v[2], v[3]);
            *(u32x2*)(ob + (size_t)row * D + col) = w;
        }
    }
    template <int KIND> DI void run(const f32x4 (&acc)[2][2][4][2], const pg8::Unit& u, int wr, int wc, int fr, int fq) const {
        if constexpr (KIND == E_ML) {
            const int row0 = u.pm * 256 + wr * 64 + fr;
            if (u.pn < 12) { const float sc = (u.pn == 2 || u.pn == 3) ? 0.125f : 1.0f; const int col0 = u.pn * 256 + wc * 32 + 8 * fq;
#pragma unroll
                for (int ai = 0; ai < 2; ++ai)
#pragma unroll
                    for (int m = 0; m < 4; ++m)
#pragma unroll
                        for (int bj = 0; bj < 2; ++bj) { const f32x4 v0 = acc[ai][bj][m][0] * sc, v1 = acc[ai][bj][m][1] * sc;
                            u32x4 w; w.x = pk2(v0[0], v0[1]); w.y = pk2(v0[2], v0[3]); w.z = pk2(v1[0], v1[1]); w.w = pk2(v1[2], v1[3]);
                            *(u32x4*)(ob + (size_t)(row0 + ai * 128 + m * 16) * 3072 + col0 + bj * 128) = w; }
                return; }
            if (wc == 0) {
#pragma unroll
                for (int ai = 0; ai < 2; ++ai)
#pragma unroll
                    for (int m = 0; m < 4; ++m) store8<E_ML>(u, row0 + ai * 128 + m * 16, 3072 + 8 * fq, acc[ai][0][m][0], acc[ai][0][m][1]); }
            return;
        }
        if constexpr (KIND == E_SC) {
            const int row0 = u.pm * 256 + wr * 64 + fr;
            if (u.pn >= 4) { const int ch = (u.pn - 4) * 128 + wc * 32 + 8 * fq;
#pragma unroll
                for (int ai = 0; ai < 2; ++ai)
#pragma unroll
                    for (int m = 0; m < 4; ++m) { const f32x4 v0 = acc[ai][0][m][0] * acc[ai][1][m][0], v1 = acc[ai][0][m][1] * acc[ai][1][m][1];
                        u32x4 w; w.x = pk2(v0[0], v0[1]); w.y = pk2(v0[2], v0[3]); w.z = pk2(v1[0], v1[1]); w.w = pk2(v1[2], v1[3]);
                        *(u32x4*)(ob + (size_t)(row0 + ai * 128 + m * 16) * 3072 + 1024 + ch) = w; }
                return; }
            const int col0 = u.pn * 256 + wc * 32 + 8 * fq;
#pragma unroll
            for (int ai = 0; ai < 2; ++ai)
#pragma unroll
                for (int m = 0; m < 4; ++m)
#pragma unroll
                    for (int bj = 0; bj < 2; ++bj) store8<E_BF16>(u, row0 + ai * 128 + m * 16, col0 + bj * 128, acc[ai][bj][m][0], acc[ai][bj][m][1]);
            return;
        }
        if constexpr (PERM) {
            const int row0 = u.pm * 256 + wr * 64 + fr, col0 = u.pn * 256 + wc * 32 + 8 * fq;
#pragma unroll
            for (int ai = 0; ai < 2; ++ai)
#pragma unroll
                for (int m = 0; m < 4; ++m)
#pragma unroll
                    for (int bj = 0; bj < 2; ++bj) store8<KIND>(u, row0 + ai * 128 + m * 16, col0 + bj * 128, acc[ai][bj][m][0], acc[ai][bj][m][1]);
            return;
        }
        const int row0 = u.pm * 256 + wr * 64 + fr, col0 = u.pn * 256 + wc * 32 + 4 * fq;
#pragma unroll
        for (int ai = 0; ai < 2; ++ai)
#pragma unroll
            for (int m = 0; m < 4; ++m)
#pragma unroll
                for (int bj = 0; bj < 2; ++bj)
#pragma unroll
                    for (int n = 0; n < 2; ++n) store4<KIND>(u, row0 + ai * 128 + m * 16, col0 + bj * 128 + n * 16, acc[ai][bj][m][n]);
    }
    DI void operator()(const f32x4 (&acc)[2][2][4][2], const pg8::Unit& u, int wr, int wc, int fr, int fq) const { run<EKIND>(acc, u, wr, wc, fr, fq); }
    DI void half(const f32x4 (&acc)[2][2][4][2], const pg8::Unit& u, int wr, int wc, int fr, int fq) const {
        const int row0 = u.pm * 256 + wr * 64 + fr, col0 = u.pn * 256 + (u.aux >> 1) * 128 + wc * 32 + 8 * fq;
#pragma unroll
        for (int ai = 0; ai < 2; ++ai)
#pragma unroll
            for (int m = 0; m < 4; ++m) store8<EKIND>(u, row0 + ai * 128 + m * 16, col0, acc[ai][0][m][0], acc[ai][0][m][1]);
    }
};

DI bool poll_ge(unsigned* word, unsigned want, unsigned* tmo) {
    unsigned polls = 0;
    for (;;) {
        if ((unsigned)__builtin_amdgcn_readfirstlane(__hip_atomic_load(word, __ATOMIC_RELAXED, __HIP_MEMORY_SCOPE_AGENT)) >= want) return true;
        if ((++polls & 255u) == 0u) {
            if (__builtin_amdgcn_readfirstlane(__hip_atomic_load(tmo, __ATOMIC_RELAXED, __HIP_MEMORY_SCOPE_AGENT)) != 0u) return false;
            if (polls > (1u << 20)) { __hip_atomic_store(tmo, 1u, __ATOMIC_RELAXED, __HIP_MEMORY_SCOPE_AGENT); return false; }
        }
        __builtin_amdgcn_s_sleep(1);
    }
}
struct EpiLNF {
    static constexpr bool AFTER_DRAIN = true, PERM = true;
    bf16_t* X; bf16_t* Xo; float* Xf; bf16_t* H; float* xb; unsigned long long* xs; unsigned* flags; unsigned* cnt; unsigned* tmo;
    const float* mod; const float* modn; const float* lng; const float* lnb; const float* bias; const float* scale;
    int goff, shoff, scoff; unsigned epoch, sepoch;
    DI void fused(f32x4 (&acc)[2][2][4][2], const pg8::Unit& u, int wr_, int wc_, int fr_, int fq_, LAS unsigned char* lds, int wid_, int lane_, int tid_) const {
        if (u.aux) fused_ks<1>(acc, u, wr_, wc_, fr_, fq_, lds, wid_, lane_, tid_); else fused_ks<0>(acc, u, wr_, wc_, fr_, fq_, lds, wid_, lane_, tid_);
    }
    template <int KSC> DI void fused_ks(f32x4 (&acc)[2][2][4][2], const pg8::Unit& u, int wr_, int wc_, int fr_, int fq_, LAS unsigned char* lds, int wid_, int lane_, int tid_) const {
        int tid = tid_; asm volatile("" : "+v"(tid));
        const int wid = __builtin_amdgcn_readfirstlane(tid >> 6), lane = tid & 63, wr = wid >> 2, wc = wid & 3, fr = lane & 15, fq = lane >> 4;
        const int tileid = u.pm * 4 + u.pn;
        constexpr int KS = KSC;
        f32x4 mine[2][4][2], oth[2][4][2];
        {
#pragma unroll
            for (int bj = 0; bj < 2; ++bj)
#pragma unroll
                for (int m = 0; m < 4; ++m)
#pragma unroll
                    for (int n = 0; n < 2; ++n) { mine[bj][m][n] = acc[KS][bj][m][n]; oth[bj][m][n] = acc[1 - KS][bj][m][n]; }
        }
        const int row0 = u.pm * 256 + KS * 128 + wr * 64 + fr, col0 = u.pn * 256 + wc * 32 + 8 * fq;
        const int cd = row_cond(u.pm * 256);
        const float* mn = modn ? modn + (size_t)cd * NMOD : nullptr;
        constexpr int PAR = 136192;
        {
            const float* src = nullptr;
            if (wid == 0) src = mod + (size_t)cd * NMOD + goff; else if (wid == 1) src = bias; else if (wid == 2) src = scale; else if (wid == 3) src = lng; else if (wid == 4) src = lnb;
            else if (wid == 5) src = mn ? mn + shoff : nullptr; else if (wid == 6) src = mn ? mn + scoff : nullptr;
            if (src) __builtin_amdgcn_global_load_lds((const unsigned*)(src + u.pn * 256 + lane * 4), (LAS unsigned*)(lds + PAR + wid * 1024), 16, 0, 0);
        }
        {
            const __amdgpu_buffer_rsrc_t rs = __builtin_amdgcn_make_buffer_rsrc(xb, 0, 256 * 65536, 0x00020000);
            const unsigned off0 = (unsigned)(tileid * 2 + KS) * 65536u + (unsigned)tid * 16u;
#pragma unroll
            for (int m = 0; m < 4; ++m)
#pragma unroll
                for (int bj = 0; bj < 2; ++bj) {
                    u32x4 w; w.x = pk2(oth[bj][m][0][0], oth[bj][m][0][1]); w.y = pk2(oth[bj][m][0][2], oth[bj][m][0][3]); w.z = pk2(oth[bj][m][1][0], oth[bj][m][1][1]); w.w = pk2(oth[bj][m][1][2], oth[bj][m][1][3]);
                    __builtin_amdgcn_raw_buffer_store_b128(w, rs, off0 + (unsigned)((m * 2 + bj) * 8192), 0, 16);
                }
        }
        u32x2 xr[2][4][2];
#pragma unroll
        for (int bj = 0; bj < 2; ++bj)
#pragma unroll
            for (int m = 0; m < 4; ++m) { const u32x4 t4 = *(const u32x4*)(X + (size_t)(row0 + m * 16) * D + col0 + bj * 128);
                xr[bj][m][0] = (u32x2){t4.x, t4.y}; xr[bj][m][1] = (u32x2){t4.z, t4.w}; }
        asm volatile("s_waitcnt vmcnt(0)" ::: "memory");
        __builtin_amdgcn_s_barrier(); asm volatile("" ::: "memory");
        if (tid == 0) __hip_atomic_store(flags + (tileid * 2 + KS) * 64, epoch, __ATOMIC_RELAXED, __HIP_MEMORY_SCOPE_AGENT);
        if (wid == 0) (void)poll_ge(flags + (tileid * 2 + (1 - KS)) * 64, epoch, tmo);
        __builtin_amdgcn_s_barrier(); asm volatile("" ::: "memory");
        {
            const char* pb = (const char*)xb + (size_t)(tileid * 2 + (1 - KS)) * 65536 + tid * 16;
#pragma unroll
            for (int i = 0; i < 8; ++i)
                __builtin_amdgcn_global_load_lds((const unsigned*)(pb + i * 8192), (LAS unsigned*)(lds + i * 8192 + wid * 1024), 16, 0, 16);
            asm volatile("s_waitcnt vmcnt(0)" ::: "memory");
#pragma unroll
            for (int bj = 0; bj < 2; ++bj)
#pragma unroll
                for (int n = 0; n < 2; ++n) {
                    const int lc = (wc * 32 + 8 * fq + bj * 128 + n * 4) * 4;
                    f32x4 gv = *(const LAS f32x4*)(lds + PAR + lc);
                    f32x4 bv = (f32x4){0.f, 0.f, 0.f, 0.f};
                    if (bias) bv = *(const LAS f32x4*)(lds + PAR + 1024 + lc);
                    if (scale) gv = gv * *(const LAS f32x4*)(lds + PAR + 2048 + lc);
#pragma unroll
                    for (int m = 0; m < 4; ++m) {
                        const u32x2 pw = *(const LAS u32x2*)(lds + (m * 2 + bj) * 8192 + tid * 16 + n * 8);
                        const f32x4 pv = (f32x4){__uint_as_float(pw.x << 16), __uint_as_float(pw.x & 0xffff0000u), __uint_as_float(pw.y << 16), __uint_as_float(pw.y & 0xffff0000u)};
                        const f32x4 y = mine[bj][m][n] + pv + bv;
                        const u32x2 xw = xr[bj][m][n];
                        const f32x4 xv = (f32x4){__uint_as_float(xw.x << 16), __uint_as_float(xw.x & 0xffff0000u), __uint_as_float(xw.y << 16), __uint_as_float(xw.y & 0xffff0000u)};
                        mine[bj][m][n] = xv * ALPHA + gv * y;
                    }
                }
        }
        LAS f32x2* P = (LAS f32x2*)(lds + 131072);
        LAS f32x2* S = (LAS f32x2*)(lds + 131072 + 4096);
#pragma unroll
        for (int m = 0; m < 4; ++m) {
            float s = 0.f;
#pragma unroll
            for (int bj = 0; bj < 2; ++bj)
#pragma unroll
                for (int n = 0; n < 2; ++n) { const f32x4 x = mine[bj][m][n]; s += (x[0] + x[1]) + (x[2] + x[3]); }
            s += __shfl_xor(s, 16); s += __shfl_xor(s, 32);
            const float mw = s * (1.0f / 64.0f); float q = 0.f;
#pragma unroll
            for (int bj = 0; bj < 2; ++bj)
#pragma unroll
                for (int n = 0; n < 2; ++n) { const f32x4 d = mine[bj][m][n] - mw; q += (d[0] * d[0] + d[1] * d[1]) + (d[2] * d[2] + d[3] * d[3]); }
            q += __shfl_xor(q, 16); q += __shfl_xor(q, 32);
            if (fq == 0) P[(wr * 64 + m * 16 + fr) * 4 + wc] = (f32x2){mw, q};
        }
        asm volatile("s_waitcnt lgkmcnt(0)" ::: "memory"); __builtin_amdgcn_s_barrier(); asm volatile("" ::: "memory");
        const int prow = wid * 16 + (lane & 15);
        const size_t grow = (size_t)(u.pm * 256 + KS * 128 + prow);
        if (lane < 16) {
            const f32x2 a = P[prow * 4 + 0], b = P[prow * 4 + 1], c = P[prow * 4 + 2], d = P[prow * 4 + 3];
            const float mt = (a.x + b.x + c.x + d.x) * 0.25f;
            const float da = a.x - mt, db = b.x - mt, dc = c.x - mt, dd = d.x - mt;
            const float m2 = (a.y + b.y) + (c.y + d.y) + 64.0f * ((da * da + db * db) + (dc * dc + dd * dd));
            __hip_atomic_store(xs + grow * 4 + u.pn, ((unsigned long long)__float_as_uint(m2) << 32) | __float_as_uint(mt), __ATOMIC_RELAXED, __HIP_MEMORY_SCOPE_AGENT);
        }
        asm volatile("s_waitcnt vmcnt(0)" ::: "memory");
        if (lane == 0) __hip_atomic_fetch_add(cnt + (u.pm * 2 + KS) * 64, 1u, __ATOMIC_RELAXED, __HIP_MEMORY_SCOPE_AGENT);
        if (wid == 0) (void)poll_ge(cnt + (u.pm * 2 + KS) * 64, 32u * sepoch, tmo);
        asm volatile("s_waitcnt lgkmcnt(0)" ::: "memory"); __builtin_amdgcn_s_barrier(); asm volatile("" ::: "memory");
        if (lane < 16) {
            float mt[4], m2[4]; float ms = 0.f;
#pragma unroll
            for (int t = 0; t < 4; ++t) { const unsigned long long w = __hip_atomic_load(xs + grow * 4 + t, __ATOMIC_RELAXED, __HIP_MEMORY_SCOPE_AGENT); mt[t] = __uint_as_float((unsigned)w); m2[t] = __uint_as_float((unsigned)(w >> 32)); ms += mt[t]; }
            const float mean = ms * 0.25f; float q = 0.f;
#pragma unroll
            for (int t = 0; t < 4; ++t) { const float dm = mt[t] - mean; q += m2[t] + 256.0f * dm * dm; }
            S[prow] = (f32x2){mean, 1.0f / sqrtf(q * (1.0f / 1024.0f) + LN_EPS)};
        }
        asm volatile("s_waitcnt lgkmcnt(0)" ::: "memory"); __builtin_amdgcn_s_barrier(); asm volatile("" ::: "memory");
        f32x2 sr[4];
#pragma unroll
        for (int m = 0; m < 4; ++m) sr[m] = S[wr * 64 + m * 16 + fr];
#pragma unroll
        for (int bj = 0; bj < 2; ++bj) {
            const int col = col0 + bj * 128, lc = (wc * 32 + 8 * fq + bj * 128) * 4;
            const f32x4 g40 = *(const LAS f32x4*)(lds + PAR + 3072 + lc), g41 = *(const LAS f32x4*)(lds + PAR + 3072 + lc + 16), b40 = *(const LAS f32x4*)(lds + PAR + 4096 + lc), b41 = *(const LAS f32x4*)(lds + PAR + 4096 + lc + 16);
            f32x4 sh0 = (f32x4){0.f, 0.f, 0.f, 0.f}, sh1 = sh0, sc0 = sh0, sc1 = sh0;
            if (mn) { sh0 = *(const LAS f32x4*)(lds + PAR + 5120 + lc); sh1 = *(const LAS f32x4*)(lds + PAR + 5120 + lc + 16); sc0 = *(const LAS f32x4*)(lds + PAR + 6144 + lc); sc1 = *(const LAS f32x4*)(lds + PAR + 6144 + lc + 16); }
#pragma unroll
            for (int m = 0; m < 4; ++m) {
                const f32x4 x0 = (mine[bj][m][0] - sr[m].x) * sr[m].y * g40 + b40, x1 = (mine[bj][m][1] - sr[m].x) * sr[m].y * g41 + b41;
                const size_t o = (size_t)(row0 + m * 16) * D + col;
                if (Xf) { *(f32x4*)(Xf + o) = x0; *(f32x4*)(Xf + o + 4) = x1; }
                else { u32x4 xw; xw.x = pk2(x0[0], x0[1]); xw.y = pk2(x0[2], x0[3]); xw.z = pk2(x1[0], x1[1]); xw.w = pk2(x1[2], x1[3]); *(u32x4*)(Xo + o) = xw; }
                if (mn) { const f32x4 h0 = x0 * (sc0 + 1.0f) + sh0, h1 = x1 * (sc1 + 1.0f) + sh1;
                    u32x4 hw; hw.x = pk2(h0[0], h0[1]); hw.y = pk2(h0[2], h0[3]); hw.z = pk2(h1[0], h1[1]); hw.w = pk2(h1[2], h1[3]); *(u32x4*)(H + o) = hw; }
            }
        }
    }
};


template <int WIN> DI void pool_fill(LAS unsigned char* lds, int tid, const bf16_t* __restrict__ X, int row0, int c0, const float* __restrict__ scp) {
    const int chunk = tid & 15, rg = tid >> 4, cb = c0 + chunk * 8, kt = chunk >> 3, kc = (chunk & 7) * 8;
    const bool ctx = row0 < NCTX; const int S = ctx ? 256 : 1024, sbase = ctx ? 0 : ((row0 - NCTX) & 1023);
    const f32x4 sc0 = *(const f32x4*)(scp + cb) + 1.0f, sc1 = *(const f32x4*)(scp + cb + 4) + 1.0f;
    const bf16_t* xp = X + (size_t)row0 * D + cb;
    const int r0 = rg * 8;
    float sum[8];
#pragma unroll
    for (int e = 0; e < 8; ++e) sum[e] = 0.f;
#define POOL_LD(r_, v_, w_) do { const int ss_ = sbase + (r_); const bool ok_ = ss_ >= 0 && ss_ < S; (w_) = ok_ ? 1.f : 0.f; \
        const u32x4 t_ = *(const u32x4*)(xp + (ptrdiff_t)(ok_ ? (r_) : r0) * D); \
        (v_)[0] = __uint_as_float(t_.x << 16); (v_)[1] = __uint_as_float(t_.x & 0xffff0000u); (v_)[2] = __uint_as_float(t_.y << 16); (v_)[3] = __uint_as_float(t_.y & 0xffff0000u); \
        (v_)[4] = __uint_as_float(t_.z << 16); (v_)[5] = __uint_as_float(t_.z & 0xffff0000u); (v_)[6] = __uint_as_float(t_.w << 16); (v_)[7] = __uint_as_float(t_.w & 0xffff0000u); } while (0)
#pragma unroll
    for (int j = 0; j < WIN; ++j) { float v[8], w; POOL_LD(r0 + j - WIN / 2, v, w);
#pragma unroll
        for (int e = 0; e < 8; ++e) sum[e] += w * v[e]; }
#pragma unroll
    for (int i = 0; i < 8; ++i) {
        const int r = r0 + i;
        if (i > 0) { float va[8], vs[8], wa, wsb; POOL_LD(r + WIN / 2 - 1, va, wa); POOL_LD(r - 1 - WIN / 2, vs, wsb);
#pragma unroll
            for (int e = 0; e < 8; ++e) sum[e] += wa * va[e] - wsb * vs[e]; }
        float vc[8], wc_; POOL_LD(r, vc, wc_); (void)wc_;
        const int s = sbase + r, lo = s - WIN / 2 < 0 ? 0 : s - WIN / 2, hi = s + WIN / 2 - 1 > S - 1 ? S - 1 : s + WIN / 2 - 1;
        const float inv = __builtin_amdgcn_rcpf((float)(hi - lo + 1));
        u32x4 o;
        o.x = pk2((sum[0] * inv - vc[0]) * sc0[0], (sum[1] * inv - vc[1]) * sc0[1]); o.y = pk2((sum[2] * inv - vc[2]) * sc0[2], (sum[3] * inv - vc[3]) * sc0[3]);
        o.z = pk2((sum[4] * inv - vc[4]) * sc1[0], (sum[5] * inv - vc[5]) * sc1[1]); o.w = pk2((sum[6] * inv - vc[6]) * sc1[2], (sum[7] * inv - vc[7]) * sc1[3]);
        *(LAS u32x4*)(lds + (kt * 2 + (r >> 7)) * pg8::HTB + pg8::lds_byte(r & 127, kc)) = o;
    }
#undef POOL_LD
}
template <class Sched> DI void pool_gemm_lnf(Frame& F, const Sched& S, const EpiLNF& E, const bf16_t* X, const float* modl2) {
    using namespace pg8;
    LAS unsigned char* lds = F.lds; const int tid = F.tid;
    Unit u; if (!S.next(0, u)) return;
    const int wid = __builtin_amdgcn_readfirstlane(tid >> 6), lane = tid & 63, wr = wid >> 2, wc = wid & 3, fr = lane & 15, fq = lane >> 4;
    const unsigned ldsw = (unsigned)wid * 1024u;
    {
        unsigned voffB[2];
#pragma unroll
        for (int i = 0; i < 2; ++i) { int R, C; stage_rc(tid * 16 + i * 8192, R, C); const int Rb = (R & ~31) + perm32(R & 31); voffB[i] = (unsigned)(Rb * 256 + C) * 2u; }
#pragma unroll
        for (int b = 0; b < 2; ++b)
#pragma unroll
            for (int h = 0; h < 2; ++h)
#pragma unroll
                for (int i = 0; i < 2; ++i)
                    __builtin_amdgcn_global_load_lds((const unsigned*)(u.b + (size_t)h * (128 * 256 * 2) + (size_t)b * 128 + voffB[i]), (LAS unsigned*)(lds + (4 + b * 2 + h) * HTB + ldsw + i * 8192), 16, 0, 0);
    }
    { const int row0 = u.pm * 256, c0 = u.pn * 256 + u.aux * 128; const float* scp = modl2 + (size_t)row_cond(row0) * NMOD + D;
      if (u.pn == 0) pool_fill<2>(lds, tid, X, row0, c0, scp); else if (u.pn == 1) pool_fill<4>(lds, tid, X, row0, c0, scp); else if (u.pn == 2) pool_fill<8>(lds, tid, X, row0, c0, scp); else pool_fill<16>(lds, tid, X, row0, c0, scp); }
    asm volatile("s_waitcnt vmcnt(0) lgkmcnt(0)" ::: "memory");
    __builtin_amdgcn_s_barrier(); asm volatile("" ::: "memory");
    f32x4 acc[2][2][4][2];
#pragma unroll
    for (int a = 0; a < 2; ++a)
#pragma unroll
        for (int b = 0; b < 2; ++b)
#pragma unroll
            for (int m = 0; m < 4; ++m)
#pragma unroll
                for (int n = 0; n < 2; ++n) acc[a][b][m][n] = (f32x4){0.f, 0.f, 0.f, 0.f};
    const int aoff = lds_byte(wr * 64 + fr, fq * 8), boff = lds_byte(wc * 32 + fr, fq * 8);
#pragma unroll
    for (int kt = 0; kt < 2; ++kt) {
        bf16x8 Bf[2][2][2];
#pragma unroll
        for (int bj = 0; bj < 2; ++bj)
#pragma unroll
            for (int n = 0; n < 2; ++n)
#pragma unroll
                for (int k = 0; k < 2; ++k) Bf[bj][n][k] = *(const LAS bf16x8*)(lds + (4 + kt * 2 + bj) * HTB + boff + n * 2048 + k * 1024);
#pragma unroll
        for (int ai = 0; ai < 2; ++ai) {
            bf16x8 At[4][2];
#pragma unroll
            for (int m = 0; m < 4; ++m)
#pragma unroll
                for (int k = 0; k < 2; ++k) At[m][k] = *(const LAS bf16x8*)(lds + (kt * 2 + ai) * HTB + aoff + m * 2048 + k * 1024);
#pragma unroll
            for (int bj = 0; bj < 2; ++bj)
#pragma unroll
                for (int m = 0; m < 4; ++m)
#pragma unroll
                    for (int n = 0; n < 2; ++n)
#pragma unroll
                        for (int k = 0; k < 2; ++k) acc[ai][bj][m][n] = __builtin_amdgcn_mfma_f32_16x16x32_bf16(Bf[bj][n][k], At[m][k], acc[ai][bj][m][n], 0, 0, 0);
        }
    }
    asm volatile("s_waitcnt lgkmcnt(0)" ::: "memory");
    __builtin_amdgcn_s_barrier(); asm volatile("" ::: "memory");
    E.fused(acc, u, wr, wc, fr, fq, lds, wid, lane, tid);
}
#ifdef NAIVE_GEMM
template <int SKIND, int EKIND> DI void gemm_run(Frame& F, const Sched<SKIND>& S, const Epi<EKIND>& E) {
    pg8::Unit u;
    for (int i = 0; S.next(i, u); ++i) {
        const bf16_t* A = (const bf16_t*)u.a; const bf16_t* B = (const bf16_t*)u.b; const int K = u.nt * 64;
        for (int e = F.tid; e < 256 * 64; e += NTHR) {
            const int r = e >> 6, c4 = (e & 63) * 4;
            f32x4 acc = (f32x4){0.f, 0.f, 0.f, 0.f};
            for (int k = 0; k < K; ++k) { const float a = bf2f(A[(size_t)r * S.lda + k]);
#pragma unroll
                for (int j = 0; j < 4; ++j) acc[j] += a * bf2f(B[(size_t)(c4 + j) * S.ldb + k]); }
            E.template store4<EKIND>(u, u.pm * 256 + r, u.pn * 256 + c4, acc);
        }
    }
}
#else
template <int SKIND, int EKIND> DI void gemm_run(Frame& F, const Sched<SKIND>& S, const Epi<EKIND>& E) { pg8::gemm_phase<Epi<EKIND>, Sched<SKIND>>(F.lds, F.tid, S.lda, S.ldb, S, E); }
#endif
template <int SKIND> DI void gemm_run_lnf(Frame& F, const Sched<SKIND>& S, const EpiLNF& E) { pg8::gemm_phase<EpiLNF, Sched<SKIND>>(F.lds, F.tid, S.lda, S.ldb, S, E); }

DI float wave_sum(float v) {
#pragma unroll
    for (int o = 1; o < 64; o <<= 1) v += __shfl_xor(v, o);
    return v;
}
DI float wave_scan_incl(float v, int lane) {
#pragma unroll
    for (int o = 1; o < 64; o <<= 1) { const float u = __shfl_up(v, o); if (lane >= o) v += u; }
    return v;
}
DI float wave_max(float v) {
#pragma unroll
    for (int o = 1; o < 64; o <<= 1) v = fmaxf(v, __shfl_xor(v, o));
    return v;
}
DI void p0_transpose_item(const float* W, int K, int N, bf16_t* WT, int row_off, LAS float* scr, int item, int lane) {
    const int nblk = N / 32, kb = item / nblk, nb = item % nblk, k0 = 64 * kb, n0 = 32 * nb;
#pragma unroll 8
    for (int i = 0; i < 32; ++i) { const int kk = 2 * i + (lane >> 5); scr[kk * 33 + (lane & 31)] = W[(size_t)(k0 + kk) * N + n0 + (lane & 31)]; }
    asm volatile("s_waitcnt lgkmcnt(0)" ::: "memory");
    const int c = lane & 7;
#pragma unroll
    for (int j = 0; j < 4; ++j) { const int n = (lane >> 3) + 8 * j; const LAS float* s = scr + (8 * c) * 33 + n;
        u32x4 o; o.x = pk2(s[0 * 33], s[1 * 33]); o.y = pk2(s[2 * 33], s[3 * 33]); o.z = pk2(s[4 * 33], s[5 * 33]); o.w = pk2(s[6 * 33], s[7 * 33]);
        *(u32x4*)(WT + (size_t)(row_off + n0 + n) * K + k0 + 8 * c) = o; }
    asm volatile("s_waitcnt lgkmcnt(0)" ::: "memory");
}

DI void p0_transpose_item64(const float* __restrict__ W, int K, int N, bf16_t* __restrict__ WT, LAS float* scr, int item, int lane, bool sc_pair = false) {
    const int nblk = N >> 6, kb = item / nblk, nb = item - kb * nblk, k0 = 64 * kb, n0 = 64 * nb;
    int d0 = n0; if (sc_pair && n0 >= 1024) { const int ch0 = (n0 - 1024) & 1023, isu = n0 >= 2048 ? 128 : 0; d0 = 1024 + (ch0 >> 7) * 256 + isu + (ch0 & 127); }
    const int lr = lane >> 4, lc = (lane & 15) * 4;
    f32x4 v[16];
#pragma unroll
    for (int i = 0; i < 16; ++i) v[i] = __builtin_nontemporal_load((const f32x4*)(W + (size_t)(k0 + 4 * i + lr) * N + n0 + lc));
#pragma unroll
    for (int i = 0; i < 16; ++i) { LAS float* d = scr + (4 * i + lr) * 65 + lc; d[0] = v[i][0]; d[1] = v[i][1]; d[2] = v[i][2]; d[3] = v[i][3]; }
    asm volatile("s_waitcnt lgkmcnt(0)" ::: "memory");
    const int c = lane & 7;
#pragma unroll
    for (int j = 0; j < 8; ++j) { const int n = (lane >> 3) + 8 * j; const LAS float* s = scr + (8 * c) * 65 + n;
        u32x4 o; o.x = pk2(s[0 * 65], s[1 * 65]); o.y = pk2(s[2 * 65], s[3 * 65]); o.z = pk2(s[4 * 65], s[5 * 65]); o.w = pk2(s[6 * 65], s[7 * 65]);
        *(u32x4*)(WT + (size_t)(d0 + n) * K + k0 + 8 * c) = o; }
    asm volatile("s_waitcnt lgkmcnt(0)" ::: "memory");
}

template <int CG> DI void mod_gemv(Frame& F, int lo, int hi, int widx, int nw) {
    constexpr int KG = NTHR / CG;
    const float* const* in = F.in;
    LAS float* sl = (LAS float*)(F.lds);
    LAS f32x4* red = (LAS f32x4*)(F.lds + 20480);
    __syncthreads();
    for (int e = F.tid; e < NCOND * D; e += NTHR) { const int cd = e >> 10, k = e & 1023; const float c = cd == 0 ? in[6][k] : in[5][(cd - 1) * D + k]; sl[e] = c * __builtin_amdgcn_rcpf(1.0f + __expf(-c)); }
    __syncthreads();
    float* MOD = (float*)(F.ws + WS_MOD);
    for (int item = lo + widx; item < hi; item += nw) {
        const int colg = item * (4 * CG), l = colg / NMOD, n0 = colg % NMOD;
        const int cg = F.tid % CG, kg = F.tid / CG;
        f32x4 acc[NCOND];
#pragma unroll
        for (int c = 0; c < NCOND; ++c) acc[c] = (f32x4){0.f, 0.f, 0.f, 0.f};
        if (kg < KG) {
            const float* wp = in[7] + (size_t)l * D * NMOD + n0 + cg * 4;
#pragma unroll (CG == 24 ? 7 : 8)
            for (int k = kg; k < D; k += KG) { const f32x4 w = __builtin_nontemporal_load((const f32x4*)(wp + (size_t)k * NMOD));
#pragma unroll
                for (int c = 0; c < NCOND; ++c) acc[c] += w * sl[c * D + k]; }
#pragma unroll
            for (int c = 0; c < NCOND; ++c) red[(kg * NCOND + c) * CG + cg] = acc[c];
        }
        __syncthreads();
        if (F.tid < NCOND * CG) { const int c = F.tid / CG, g = F.tid % CG; f32x4 s = *(const f32x4*)(in[8] + (size_t)l * NMOD + n0 + g * 4);
            for (int q = 0; q < KG; ++q) s += red[(q * NCOND + c) * CG + g];
            *(f32x4*)(MOD + ((size_t)l * NCOND + c) * NMOD + n0 + g * 4) = s; }
        __syncthreads();
    }
    __syncthreads();
}
DI int convert_count(int grp) { return grp == 0 ? 784 : grp == 1 ? 2304 : grp == 2 ? 3072 : grp == 3 ? 2112 : 2304; }
DI void convert_group(Frame& F, int grp, int first, int stride, int lo = 0, int hi = 1 << 30) {
    const float* const* in = F.in;
    LAS float* scr = (LAS float*)(F.lds + F.wave * 16640);
    const int n = hi < convert_count(grp) ? hi : convert_count(grp);
    for (int it = lo + first; it < n; it += stride) {
        int r = it;
        if (grp == 0) {
            if (r < 768) p0_transpose_item64(in[13], 1024, 3072, (bf16_t*)(F.ws + WS_WT_MLIN), scr, r, F.lane);
            else p0_transpose_item(in[14], 1024, 32, (bf16_t*)(F.ws + WS_WT_MLIN), 3072, scr, r - 768, F.lane);
            continue;
        }
        const int l = grp - 1;
        const int nhead = grp == 1 ? 256 : grp == 2 ? 1024 : grp == 3 ? 64 : 256;
        if (r < nhead) {
            if (grp == 1) p0_transpose_item64(in[17], 1024, 1024, (bf16_t*)(F.ws + WS_WT_MLOUT), scr, r, F.lane);
            else if (grp == 2) { if (r < 768) p0_transpose_item64(in[18], 1024, 3072, (bf16_t*)(F.ws + WS_WT_SCIN), scr, r, F.lane, true); else p0_transpose_item64(in[20], 1024, 1024, (bf16_t*)(F.ws + WS_WT_SCOUT), scr, r - 768, F.lane); }
            else if (grp == 3) { const int g = r >> 4; p0_transpose_item64(in[21] + (size_t)g * 65536, 256, 256, (bf16_t*)(F.ws + WS_WT_PL) + (size_t)g * 65536, scr, r & 15, F.lane); }
            else p0_transpose_item64(in[24], 1024, 1024, (bf16_t*)(F.ws + WS_WT_FT), scr, r, F.lane);
            continue;
        }
        r -= nhead;
        if (r < 1024) p0_transpose_item64(in[11] + (size_t)l * D * FF, 1024, 4096, (bf16_t*)(F.ws + WS_WT_W1) + (size_t)l * D * FF, scr, r, F.lane);
        else p0_transpose_item64(in[12] + (size_t)l * D * FF, 4096, 1024, (bf16_t*)(F.ws + WS_WT_W2) + (size_t)l * D * FF, scr, r - 1024, F.lane);
    }
}
DI void make_twiddles(Frame& F, int gt, int ngt) {
    bf16_t* WC = (bf16_t*)(F.ws + WS_WC); bf16_t* T256 = (bf16_t*)(F.ws + WS_T256); bf16_t* T1024 = (bf16_t*)(F.ws + WS_T1024);
    for (int i = gt; i < 512 * 256; i += ngt) {
        { const int row = i >> 8, k = i & 255, part = row >> 8, c = row & 255; const int r = (c * k) & 255; float sn, cs; sincospif((float)r * (2.0f / 256.0f), &sn, &cs); WC[i] = (bf16_t)f2bf(part ? sn : cs); }
        { const int sp = i >> 9, col = i & 511, part = col >> 8, s = col & 255; const int r = (sp * s) & 255; float sn, cs; sincospif((float)r * (2.0f / 256.0f), &sn, &cs); T256[i] = (bf16_t)f2bf(part ? -sn : cs); }
    }
    for (int i = gt; i < 1024 * 2048; i += ngt) { const int sp = i >> 11, col = i & 2047, part = col >> 10, s = col & 1023; const int r = (sp * s) & 1023; float sn, cs; sincospif((float)r * (2.0f / 1024.0f), &sn, &cs); T1024[i] = (bf16_t)f2bf(part ? -sn : cs); }
}
DI void phase_prologue_a(Frame& F) {
    mod_gemv<8>(F, 0, 192, F.bid, F.G);
    convert_group(F, 0, F.bid * NWAVES + F.wave, F.G * NWAVES);
    const int gt = F.bid * NTHR + F.tid, NGT = F.G * NTHR;
    u32x4* z = (u32x4*)((bf16_t*)(F.ws + WS_WT_MLIN) + (size_t)3104 * 1024);
    for (int i = gt; i < 224 * 1024 / 8; i += NGT) z[i] = (u32x4){0u, 0u, 0u, 0u};
    float* POS = (float*)(F.ws + WS_POS);
    for (int i = gt; i < 80 * 512; i += NGT) { const int p = i >> 9, c = i & 511, jj = c & 255; const float omega = __expf(-(float)jj * (9.210340371976184f / 256.0f));
        const float arg = (float)(p < 16 ? p : p - 16) * omega; POS[i] = (c & 256) ? __cosf(arg) : __sinf(arg); }
}
DI void tail_ml_in(Frame& F) {
    volatile LAS unsigned* st = (volatile LAS unsigned*)(F.lds + LDS_BYTES - 64);
    const int rk = (int)__builtin_amdgcn_readfirstlane(st[3]), xi = (int)__builtin_amdgcn_readfirstlane(st[4]), un = (int)__builtin_amdgcn_readfirstlane(st[5]);
    const bool idle = un ? (rk >= 20) : (F.bid >= 160);
    if (idle) { const int widx = un ? xi * 12 + rk - 20 : F.bid - 160, nw = un ? 96 : F.G - 160;
        convert_group(F, 1, widx * NWAVES + F.wave, nw * NWAVES, 0, 256);
        mod_gemv<24>(F, 64, 256, widx, nw); }
}
DI void tail_scan(Frame& F, int half) {
    __syncthreads();
    for (int v = 2 * (F.bid * NWAVES + F.wave) + half; v < 3072; v += 2 * F.G * NWAVES) {
        if (v < 1024) convert_group(F, 2, 0, 1 << 30, v, v + 1); else convert_group(F, 1, 0, 1 << 30, 256 + (v - 1024), 256 + (v - 1024) + 1); }
}
DI void tail_sc_in(Frame& F) {
    const bool idle = F.uni ? (F.rank >= 16) : (F.bid >= 128);
    if (idle) { const int widx = F.uni ? F.xidx * 16 + F.rank - 16 : F.bid - 128, nw = F.uni ? 128 : F.G - 128;
        convert_group(F, 2, widx * NWAVES + F.wave, nw * NWAVES, 1024);
        convert_group(F, 3, widx * NWAVES + F.wave, nw * NWAVES);
        make_twiddles(F, widx * NTHR + F.tid, nw * NTHR); }
}
DI void tail_f2(Frame& F) {
    if (F.uni) {
        if (F.xidx < 4) { const int widx = F.xidx * 32 + F.rank; convert_group(F, 4, widx * NWAVES + F.wave, 128 * NWAVES); }
    } else if (F.bid >= 64) { const int widx = F.bid - 64, nw = F.G - 64; convert_group(F, 4, widx * NWAVES + F.wave, nw * NWAVES); }
}

DI void phase_prologue_b(Frame& F) {
    const ItemIter it = wave_items(F, MTOK);
    const float* MOD = (const float*)(F.ws + WS_MOD);
    bf16_t* H = (bf16_t*)(F.ws + WS_H);
    for (int q = it.start; q < it.per; q += it.stride) {
        const int row = it.base + q;
        const int cd = row_cond(row);
        const float* src = row < NCTX ? F.in[0] + (size_t)row * D : F.in[1] + (size_t)(row - NCTX) * D;
        const float* md = MOD + (size_t)cd * NMOD;
        int gr = 0, gc = 0; if (row >= NCTX) { const int t = (row - NCTX) & 1023; gr = t >> 6; gc = t & 63; }
#pragma unroll
        for (int j = 0; j < 4; ++j) {
            const int col = 4 * F.lane + 256 * j;
            f32x4 v = __builtin_nontemporal_load((const f32x4*)(src + col));
            if (row >= NCTX) v += *(const f32x4*)((const float*)(F.ws + WS_POS) + (size_t)(j < 2 ? gr : 16 + gc) * 512 + (col & 511));
            { u32x2 xw; xw.x = pk2(v[0], v[1]); xw.y = pk2(v[2], v[3]); *(u32x2*)((bf16_t*)(F.ws + WS_X16) + (size_t)row * D + col) = xw; }
            const f32x4 sh = *(const f32x4*)(md + col), sc = *(const f32x4*)(md + D + col);
            const f32x4 h = v * (sc + 1.0f) + sh;
            u32x2 w; w.x = pk2(h[0], h[1]); w.y = pk2(h[2], h[3]);
            *(u32x2*)(H + (size_t)row * D + col) = w;
        }
    }
}

DI void phase_ln(Frame& F, int l, int sub, int nsplit, const float* bias) {
    const int gw = F.bid * NWAVES + F.wave, NGW = F.G * NWAVES;
    const float* MOD = (const float*)(F.ws + WS_MOD);
    const float* Y = (const float*)(F.ws + WS_Y);
    bf16_t* H = (bf16_t*)(F.ws + WS_H);
    const float* lg = F.in[9] + (size_t)(l * 2 + sub) * D; const float* lb = F.in[10] + (size_t)(l * 2 + sub) * D;
    const int goff = sub == 0 ? 2 * D : 5 * D;
    const bool has_next = !(l == 3 && sub == 1);
    const int nl = sub == 0 ? l : l + 1, shoff = sub == 0 ? 3 * D : 0, scoff = sub == 0 ? 4 * D : D;
    for (int row = gw; row < MTOK; row += NGW) {
        const int cd = row_cond(row);
        const float* md = MOD + ((size_t)l * NCOND + cd) * NMOD;
        f32x4 v[4]; float s = 0.f;
#pragma unroll
        for (int j = 0; j < 4; ++j) {
            const int col = 4 * F.lane + 256 * j;
            f32x4 y = *(const f32x4*)(Y + (size_t)row * D + col);
            if (nsplit > 1) y += *(const f32x4*)(Y + (size_t)MTOK * D + (size_t)row * D + col);
            if (bias) y += *(const f32x4*)(bias + col);
            const f32x4 x = *(const f32x4*)(F.out + (size_t)row * D + col);
            const f32x4 g = *(const f32x4*)(md + goff + col);
            v[j] = x * ALPHA + g * y;
            s += (v[j][0] + v[j][1]) + (v[j][2] + v[j][3]);
        }
        const float mean = wave_sum(s) * (1.f / D); float s2 = 0.f;
#pragma unroll
        for (int j = 0; j < 4; ++j) { v[j] = v[j] - mean; s2 += (v[j][0] * v[j][0] + v[j][1] * v[j][1]) + (v[j][2] * v[j][2] + v[j][3] * v[j][3]); }
        const float rstd = 1.f / sqrtf(wave_sum(s2) * (1.f / D) + LN_EPS);
        const float* mdn = MOD + ((size_t)(has_next ? nl : 0) * NCOND + cd) * NMOD;
#pragma unroll
        for (int j = 0; j < 4; ++j) {
            const int col = 4 * F.lane + 256 * j;
            const f32x4 xn = v[j] * rstd * *(const f32x4*)(lg + col) + *(const f32x4*)(lb + col);
            *(f32x4*)(F.out + (size_t)row * D + col) = xn;
            if (has_next) {
                const f32x4 sh = *(const f32x4*)(mdn + shoff + col), sc = *(const f32x4*)(mdn + scoff + col);
                const f32x4 h = xn * (sc + 1.0f) + sh;
                u32x2 w; w.x = pk2(h[0], h[1]); w.y = pk2(h[2], h[3]);
                *(u32x2*)(H + (size_t)row * D + col) = w;
            }
        }
    }
}

typedef float f32x16 __attribute__((ext_vector_type(16)));
DI int crow(int i, int h) { return (i & 3) + 8 * (i >> 2) + 4 * h; }
DI bf16x8 gather8(const LAS bf16_t* p, int pitch) { bf16x8 r;
#pragma unroll
    for (int j = 0; j < 8; ++j) r[j] = (short)p[j * pitch];
    return r; }
constexpr int KP = 72, VP = 136;
DI void phase_s1(Frame& F) {
    LAS bf16_t* kb = (LAS bf16_t*)F.lds;
    LAS bf16_t* vb = kb + 64 * KP;
    LAS float* wv = (LAS float*)(vb + 64 * VP);
    LAS float* gl = wv + 128;
    LAS float* red = gl + 256;
    const bf16_t* QKVO = (const bf16_t*)(F.ws + WS_QKVO);
    const float* GATES = (const float*)(F.ws + WS_GATES);
    float* L = (float*)(F.ws + WS_L); float* NL = (float*)(F.ws + WS_NL); float* MLOC = (float*)(F.ws + WS_MLOC); float* BLAST = (float*)(F.ws + WS_BLAST);
    const int tid = F.tid, lane = F.lane, r = lane & 31, hh = lane >> 5, w = F.wave, dt = w & 1, vt = w >> 1;
    const ItemIter it = wg_items(F, 1024);
    for (int q = it.start; q < it.per; q += it.stride) {
        const int item = it.base + q;
        const int gb = item >> 3, h = item & 7, row0 = gb * 64;
        __syncthreads();
        { const int j = tid >> 3, c8 = (tid & 7) * 8, c16 = (tid & 7) * 16;
          *(LAS u32x4*)(kb + j * KP + c8) = *(const u32x4*)(QKVO + (size_t)(row0 + j) * 3072 + 512 + h * 64 + c8);
          *(LAS u32x4*)(vb + j * VP + c16) = *(const u32x4*)(QKVO + (size_t)(row0 + j) * 3072 + 1024 + h * 128 + c16);
          *(LAS u32x4*)(vb + j * VP + c16 + 8) = *(const u32x4*)(QKVO + (size_t)(row0 + j) * 3072 + 1024 + h * 128 + c16 + 8);
          if (tid < 256) { const int d = tid >> 7, io = (tid >> 6) & 1, jj = tid & 63; gl[(io * 2 + d) * 64 + jj] = GATES[(size_t)(row0 + jj) * 32 + d * 16 + io * 8 + h]; } }
        __syncthreads();
        if (tid < 128) {
            const int d = tid >> 6, j = tid & 63; const float f = gl[(2 + d) * 64 + j];
            const float P = wave_scan_incl(f, j), tot = __shfl(P, 63);
            const float e = d == 0 ? tot - P : P - f;
            const float a = e + gl[d * 64 + j];
            const float mloc = wave_max(a);
            wv[d * 64 + j] = __expf(a - mloc);
            if (j == 0) { red[d] = mloc; red[2 + d] = tot; }
        }
        __syncthreads();
        f32x16 acc0, acc1; float nl0 = 0.f, nl1 = 0.f;
#pragma unroll
        for (int i = 0; i < 16; ++i) { acc0[i] = 0.f; acc1[i] = 0.f; }
#pragma unroll
        for (int kk = 0; kk < 4; ++kk) {
            const int tok0 = 16 * kk + 8 * hh;
            const bf16x8 kv = gather8(kb + tok0 * KP + 32 * dt + r, KP);
            const bf16x8 bv = gather8(vb + tok0 * VP + 32 * vt + r, VP);
            u32x4 a0, a1;
#pragma unroll
            for (int e = 0; e < 4; ++e) { const float k0 = bf2f((unsigned short)kv[2 * e]), k1 = bf2f((unsigned short)kv[2 * e + 1]);
                const float p00 = k0 * wv[tok0 + 2 * e], p01 = k1 * wv[tok0 + 2 * e + 1], p10 = k0 * wv[64 + tok0 + 2 * e], p11 = k1 * wv[64 + tok0 + 2 * e + 1];
                nl0 += p00 + p01; nl1 += p10 + p11;
                a0[e] = pk2(p00, p01); a1[e] = pk2(p10, p11); }
            acc0 = __builtin_amdgcn_mfma_f32_32x32x16_bf16(__builtin_bit_cast(bf16x8, a0), bv, acc0, 0, 0, 0);
            acc1 = __builtin_amdgcn_mfma_f32_32x32x16_bf16(__builtin_bit_cast(bf16x8, a1), bv, acc1, 0, 0, 0);
        }
        const size_t idx0 = (size_t)(gb * 8 + h) * 2;
#pragma unroll
        for (int i = 0; i < 16; ++i) { const int dq = 32 * dt + crow(i, hh); L[idx0 * 8192 + dq * 128 + 32 * vt + r] = acc0[i]; L[(idx0 + 1) * 8192 + dq * 128 + 32 * vt + r] = acc1[i]; }
        nl0 += __shfl_xor(nl0, 32); nl1 += __shfl_xor(nl1, 32);
        if (vt == 0 && hh == 0) { NL[idx0 * 64 + 32 * dt + r] = nl0; NL[(idx0 + 1) * 64 + 32 * dt + r] = nl1; }
        if (tid < 2) { MLOC[idx0 + tid] = red[tid]; BLAST[idx0 + tid] = red[2 + tid]; }
    }
}

template <int NC> DI void s2_item(Frame& F, int seq, int h, int d, int slab, int gb0) {
    const float* __restrict__ L = (const float*)(F.ws + WS_L); const float* __restrict__ NL = (const float*)(F.ws + WS_NL);
    const float* __restrict__ MLOC = (const float*)(F.ws + WS_MLOC); const float* __restrict__ BLAST = (const float*)(F.ws + WS_BLAST);
    bf16_t* __restrict__ CINIT = (bf16_t*)(F.ws + WS_H1); float* __restrict__ NINIT = (float*)(F.ws + WS_NINIT); float* __restrict__ MINIT = (float*)(F.ws + WS_MINIT);
    const int tid = F.tid, e4 = (slab * 512 + tid) * 4;
    const bool nthread = (slab == 0 && tid < 64);
    f32x4 C = (f32x4){0.f, 0.f, 0.f, 0.f}; float n = 0.f, m = 0.f;
    if (seq >= 16) { const size_t base = (size_t)((seq - 16) * 2 + d) * 8 + h; C = *(const f32x4*)(F.in[2] + base * 8192 + e4); if (nthread) n = F.in[3][base * 64 + tid]; m = F.in[4][base]; }
    f32x4 Lv[NC]; float nl[NC], f1[NC], f2[NC], mi[NC];
#pragma unroll
    for (int c = 0; c < NC; ++c) {
        const int gb = d == 0 ? gb0 + c : gb0 + NC - 1 - c; const size_t idx = (size_t)(gb * 8 + h) * 2 + d;
        Lv[c] = *(const f32x4*)(L + idx * 8192 + e4); nl[c] = nthread ? NL[idx * 64 + tid] : 0.f;
        const float bl = BLAST[idx], ml = MLOC[idx], mn = fmaxf(bl + m, ml);
        mi[c] = m; f1[c] = expf(bl + m - mn); f2[c] = expf(ml - mn); m = mn;
    }
#pragma unroll
    for (int c = 0; c < NC; ++c) {
        const int gb = d == 0 ? gb0 + c : gb0 + NC - 1 - c; const size_t idx = (size_t)(gb * 8 + h) * 2 + d;
        { u32x2 cw; cw.x = pk2(C[0], C[1]); cw.y = pk2(C[2], C[3]); *(u32x2*)(CINIT + idx * 8192 + e4) = cw; }
        if (nthread) NINIT[idx * 64 + tid] = n;
        if (slab == 0 && tid == 0) MINIT[idx] = mi[c];
        C = C * f1[c] + Lv[c] * f2[c]; n = n * f1[c] + nl[c] * f2[c];
    }
    if (seq < 16) { const size_t ob = (size_t)(seq * 2 + d) * 8 + h; *(f32x4*)(F.out + OUT_NEWC + ob * 8192 + e4) = C; if (nthread) F.out[OUT_NEWN + ob * 64 + tid] = n; if (slab == 0 && tid == 0) F.out[OUT_NEWM + ob] = m; }
}
DI void phase_s2(Frame& F) {
    const int s2_start = F.uni ? F.rank : F.bid, s2_stride = F.uni ? 32 : F.G, s2_per = F.uni ? (F.xidx < 4 ? 256 : 64) : 1280, s2_base = F.uni ? (F.xidx < 4 ? 256 * F.xidx : 1024 + 64 * (F.xidx - 4)) : 0;
    for (int q = s2_start; q < s2_per; q += s2_stride) {
        const int item = s2_base + q;
        const int st = item >> 2, slab = item & 3, seq = st >> 4, h = (st >> 1) & 7, d = st & 1;
        if (seq < 16) s2_item<4>(F, seq, h, d, slab, seq * 4);
        else s2_item<16>(F, seq, h, d, slab, 64 + (seq - 16) * 16);
    }
}

DI void phase_s3(Frame& F) {
    LAS bf16_t* qb = (LAS bf16_t*)F.lds;
    LAS bf16_t* kb = qb + 64 * KP;
    LAS bf16_t* vb = kb + 64 * KP;
    LAS bf16_t* cfb = vb + 64 * VP;
    LAS bf16_t* cbb = cfb + 64 * VP;
    LAS bf16_t* ob = cbb + 64 * VP;
    LAS bf16_t* zo = ob + 64 * VP;
    LAS float* gl = (LAS float*)(zo + 64 * VP);
    LAS float* cum = gl + 256;
    LAS float* suf = cum + 64;
    LAS float* nfb = suf + 64;
    LAS float* red = nfb + 128;
    LAS float* pmx = red + 512;
    LAS float* psm = pmx + 512;
    LAS bf16_t* pfb = (LAS bf16_t*)(psm + 512);
    LAS bf16_t* pbb = pfb + 64 * KP;
    const bf16_t* QKVO = (const bf16_t*)(F.ws + WS_QKVO);
    const float* GATES = (const float*)(F.ws + WS_GATES);
    const bf16_t* CINIT = (const bf16_t*)(F.ws + WS_H1); const float* NINIT = (const float*)(F.ws + WS_NINIT); const float* MINIT = (const float*)(F.ws + WS_MINIT);
    bf16_t* HS = (bf16_t*)(F.ws + WS_HS);
    const float* norm_g = F.in[16];
    const int w = F.wave, tt = w & 1, vt = w >> 1;
    const ItemIter it = wg_items(F, 1024);
    for (int q = it.start; q < it.per; q += it.stride) {
        const int item = it.base + q;
        int tid = F.tid; asm volatile("" : "+v"(tid));
        const int lane = tid & 63, r = lane & 31, hh = lane >> 5;
        const int gb = item >> 3, h = item & 7, row0 = gb * 64;
        const size_t idx0 = (size_t)(gb * 8 + h) * 2;
        __syncthreads();
        { const int j = tid >> 3, c8 = (tid & 7) * 8, c16 = (tid & 7) * 16;
          const bf16_t* src = QKVO + (size_t)(row0 + j) * 3072 + h * 64 + c8;
          *(LAS u32x4*)(qb + j * KP + c8) = *(const u32x4*)(src);
          *(LAS u32x4*)(kb + j * KP + c8) = *(const u32x4*)(src + 512);
          const bf16_t* vsrc = QKVO + (size_t)(row0 + j) * 3072 + 1024 + h * 128 + c16;
          *(LAS u32x4*)(vb + j * VP + c16) = *(const u32x4*)(vsrc); *(LAS u32x4*)(vb + j * VP + c16 + 8) = *(const u32x4*)(vsrc + 8);
          *(LAS u32x4*)(ob + j * VP + c16) = *(const u32x4*)(vsrc + 1024); *(LAS u32x4*)(ob + j * VP + c16 + 8) = *(const u32x4*)(vsrc + 1024 + 8);
          const bf16_t* cf = CINIT + idx0 * 8192 + j * 128 + c16; const bf16_t* cb = cf + 8192;
          *(LAS u32x4*)(cfb + j * VP + c16) = *(const u32x4*)(cf); *(LAS u32x4*)(cfb + j * VP + c16 + 8) = *(const u32x4*)(cf + 8);
          *(LAS u32x4*)(cbb + j * VP + c16) = *(const u32x4*)(cb); *(LAS u32x4*)(cbb + j * VP + c16 + 8) = *(const u32x4*)(cb + 8);
          if (tid < 256) { const int d = tid >> 7, io = (tid >> 6) & 1, jj = tid & 63; gl[(io * 2 + d) * 64 + jj] = GATES[(size_t)(row0 + jj) * 32 + d * 16 + io * 8 + h]; }
          if (tid < 128) nfb[tid] = NINIT[(idx0 + (tid >> 6)) * 64 + (tid & 63)]; }
        const float mf = MINIT[idx0], mb = MINIT[idx0 + 1];
        __syncthreads();
        if (tid < 128) { const int d = tid >> 6, j = tid & 63; const float f = gl[(2 + d) * 64 + j];
            const float P = wave_scan_incl(f, j);
            if (d == 0) cum[j] = P; else suf[j] = __shfl(P, 63) - P + f; }
        __syncthreads();
        const int t = 32 * tt + r;
        const int stw = vt >> 1, gq = (vt & 1) * 2;
        f32x16 X;
#pragma unroll
        for (int i = 0; i < 16; ++i) X[i] = 0.f;
#pragma unroll
        for (int kk = 0; kk < 4; ++kk) X = __builtin_amdgcn_mfma_f32_32x32x16_bf16(*(const LAS bf16x8*)(kb + (32 * stw + r) * KP + 16 * kk + 8 * hh), *(const LAS bf16x8*)(qb + t * KP + 16 * kk + 8 * hh), X, 0, 0, 0);
        float xs[8];
#pragma unroll
        for (int i = 0; i < 8; ++i) xs[i] = (vt & 1) ? X[8 + i] : X[i];
        float qnf = 0.f, qnb = 0.f;
#pragma unroll
        for (int c = 0; c < 4; ++c) { const bf16x8 qv = *(const LAS bf16x8*)(qb + t * KP + 32 * hh + 8 * c);
#pragma unroll
            for (int j = 0; j < 8; ++j) { const float q = bf2f((unsigned short)qv[j]); qnf += q * nfb[32 * hh + 8 * c + j]; qnb += q * nfb[64 + 32 * hh + 8 * c + j]; } }
        qnf += __shfl_xor(qnf, 32); qnb += __shfl_xor(qnb, 32);
        const float ct = cum[t], stt = suf[t];
        float df[8], db[8]; float pmf = -3.0e38f, pmb = -3.0e38f;
#pragma unroll
        for (int gg = 0; gg < 2; ++gg) { const int s0 = 32 * stw + 8 * (gq + gg) + 4 * hh;
            const f32x4 c4 = *(const LAS f32x4*)(cum + s0), i0 = *(const LAS f32x4*)(gl + s0), s4 = *(const LAS f32x4*)(suf + s0), i1 = *(const LAS f32x4*)(gl + 64 + s0);
#pragma unroll
            for (int e = 0; e < 4; ++e) { const int s = s0 + e, i = 4 * gg + e;
                const float nf = __int_as_float(((t - s) >> 31) & (int)0xF149F2CAu), nb = __int_as_float(((s - t) >> 31) & (int)0xF149F2CAu);
                df[i] = ct - c4[e] + i0[e] + nf; db[i] = stt - s4[e] + i1[e] + nb;
                pmf = fmaxf(pmf, df[i]); pmb = fmaxf(pmb, db[i]); } }
        pmf = fmaxf(pmf, __shfl_xor(pmf, 32)); pmb = fmaxf(pmb, __shfl_xor(pmb, 32));
        if (hh == 0) { pmx[vt * 64 + t] = pmf; pmx[256 + vt * 64 + t] = pmb; }
        __syncthreads();
        float mxf = ct + mf, mxb = stt + mb;
#pragma unroll
        for (int v4 = 0; v4 < 4; ++v4) { mxf = fmaxf(mxf, pmx[v4 * 64 + t]); mxb = fmaxf(mxb, pmx[256 + v4 * 64 + t]); }
        float sumf = 0.f, sumb = 0.f;
#pragma unroll
        for (int i = 0; i < 8; ++i) { df[i] = xs[i] * __expf(df[i] - mxf); db[i] = xs[i] * __expf(db[i] - mxb); sumf += df[i]; sumb += db[i]; }
        sumf += __shfl_xor(sumf, 32); sumb += __shfl_xor(sumb, 32);
        if (hh == 0) { psm[vt * 64 + t] = sumf; psm[256 + vt * 64 + t] = sumb; }
#pragma unroll
        for (int gg = 0; gg < 2; ++gg) { const int s0 = 32 * stw + 8 * (gq + gg) + 4 * hh;
            u32x2 wf, wb; wf.x = pk2(df[4 * gg], df[4 * gg + 1]); wf.y = pk2(df[4 * gg + 2], df[4 * gg + 3]); wb.x = pk2(db[4 * gg], db[4 * gg + 1]); wb.y = pk2(db[4 * gg + 2], db[4 * gg + 3]);
            *(LAS u32x2*)(pfb + t * KP + s0) = wf; *(LAS u32x2*)(pbb + t * KP + s0) = wb; }
        __syncthreads();
        sumf = 0.f; sumb = 0.f;
#pragma unroll
        for (int v4 = 0; v4 < 4; ++v4) { sumf += psm[v4 * 64 + t]; sumb += psm[256 + v4 * 64 + t]; }
        const float af = __expf(ct + mf - mxf), ab = __expf(stt + mb - mxb);
        const float rf = __builtin_amdgcn_rcpf(fmaxf(fabsf(sumf + af * qnf), __expf(-mxf))), rb = __builtin_amdgcn_rcpf(fmaxf(fabsf(sumb + ab * qnb), __expf(-mxb)));
        f32x16 zp, zq, zf, zb;
#pragma unroll
        for (int i = 0; i < 16; ++i) { zp[i] = 0.f; zq[i] = 0.f; zf[i] = 0.f; zb[i] = 0.f; }
#pragma unroll
        for (int ks = 0; ks < 4; ++ks) {
            const bf16x8 av = gather8(vb + (16 * ks + 8 * hh) * VP + 32 * vt + r, VP);
            zp = __builtin_amdgcn_mfma_f32_32x32x16_bf16(av, *(const LAS bf16x8*)(pfb + t * KP + 16 * ks + 8 * hh), zp, 0, 0, 0);
            zq = __builtin_amdgcn_mfma_f32_32x32x16_bf16(av, *(const LAS bf16x8*)(pbb + t * KP + 16 * ks + 8 * hh), zq, 0, 0, 0);
        }
        asm volatile("" ::: "memory");
#pragma unroll
        for (int kk = 0; kk < 4; ++kk) {
            const bf16x8 a0 = gather8(cfb + (16 * kk + 8 * hh) * VP + 32 * vt + r, VP), a1 = gather8(cbb + (16 * kk + 8 * hh) * VP + 32 * vt + r, VP);
            const bf16x8 bq = *(const LAS bf16x8*)(qb + t * KP + 16 * kk + 8 * hh);
            zf = __builtin_amdgcn_mfma_f32_32x32x16_bf16(a0, bq, zf, 0, 0, 0);
            zb = __builtin_amdgcn_mfma_f32_32x32x16_bf16(a1, bq, zb, 0, 0, 0);
        }
        float s1 = 0.f, s2 = 0.f;
#pragma unroll
        for (int i = 0; i < 16; ++i) { zp[i] = rf * (zp[i] + af * zf[i]) + rb * (zq[i] + ab * zb[i]); s1 += zp[i]; s2 += zp[i] * zp[i]; }
        s1 += __shfl_xor(s1, 32); s2 += __shfl_xor(s2, 32);
        if (hh == 0) { red[((tt * 4 + vt) * 32 + r) * 2] = s1; red[((tt * 4 + vt) * 32 + r) * 2 + 1] = s2; }
        __syncthreads();
        float a1s = 0.f, a2s = 0.f;
#pragma unroll
        for (int q = 0; q < 4; ++q) { a1s += red[((tt * 4 + q) * 32 + r) * 2]; a2s += red[((tt * 4 + q) * 32 + r) * 2 + 1]; }
        const float mu = a1s * (1.0f / 128.0f), var = fmaxf(a2s * (1.0f / 128.0f) - mu * mu, 0.f), rstd = __builtin_amdgcn_rsqf(var + LN_EPS);
#pragma unroll
        for (int g4 = 0; g4 < 4; ++g4) {
            const int v0 = 32 * vt + 8 * g4 + 4 * hh;
            const u32x2 ov = *(const LAS u32x2*)(ob + t * VP + v0);
            const f32x4 g = *(const f32x4*)(norm_g + h * 128 + v0);
            const float o0 = __uint_as_float(ov.x << 16), o1 = __uint_as_float(ov.x & 0xffff0000u), o2 = __uint_as_float(ov.y << 16), o3 = __uint_as_float(ov.y & 0xffff0000u);
            u32x2 wv2;
            wv2.x = pk2((zp[4 * g4] - mu) * rstd * g[0] * sigmoidf_(o0), (zp[4 * g4 + 1] - mu) * rstd * g[1] * sigmoidf_(o1));
            wv2.y = pk2((zp[4 * g4 + 2] - mu) * rstd * g[2] * sigmoidf_(o2), (zp[4 * g4 + 3] - mu) * rstd * g[3] * sigmoidf_(o3));
            *(LAS u32x2*)(zo + t * VP + v0) = wv2;
        }
        __syncthreads();
        { const int j = tid >> 3, c16 = (tid & 7) * 16; bf16_t* dst = HS + (size_t)(row0 + j) * D + h * 128 + c16;
          *(u32x4*)(dst) = *(const LAS u32x4*)(zo + j * VP + c16); *(u32x4*)(dst + 8) = *(const LAS u32x4*)(zo + j * VP + c16 + 8); }
    }
}

DI void phase_conv(Frame& F) {
    const bf16_t* __restrict__ BCU = (const bf16_t*)(F.ws + WS_QKVO); bf16_t* __restrict__ HS = (bf16_t*)(F.ws + WS_HS);
    const float* __restrict__ cw = F.in[19];
    const ItemIter it = thr_items(F, MTOK * 128);
    const int NGT = it.stride, NTOT = it.base + it.per;
    constexpr int UNR = 4;
    for (int i0 = it.base + it.start; i0 < NTOT; i0 += UNR * NGT) {
        u32x4 cg[UNR][3], bg[UNR]; float wgt[UNR][3];
#pragma unroll
        for (int q = 0; q < UNR; ++q) {
            int i = i0 + q * NGT; if (i >= NTOT) i = NTOT - 1;
            const int row = i >> 7, c8 = (i & 127) * 8;
            const int s = row < NCTX ? (row & 255) : ((row - NCTX) & 1023), S = row < NCTX ? 256 : 1024;
#pragma unroll
            for (int j = 0; j < 3; ++j) { const int ss = s + j - 1; const bool ok = ss >= 0 && ss < S; const size_t r2 = (size_t)(ok ? row + j - 1 : row);
                wgt[q][j] = ok ? 1.f : 0.f; cg[q][j] = *(const u32x4*)(BCU + r2 * 3072 + 1024 + c8); }
            bg[q] = *(const u32x4*)(BCU + (size_t)row * 3072 + c8);
        }
#pragma unroll
        for (int q = 0; q < UNR; ++q) {
            const int i = i0 + q * NGT; if (i >= NTOT) break;
            const int row = i >> 7, c8 = (i & 127) * 8;
            float accv[8];
#pragma unroll
            for (int e = 0; e < 8; ++e) accv[e] = 0.f;
#pragma unroll
            for (int j = 0; j < 3; ++j) {
                const f32x4 w0 = *(const f32x4*)(cw + j * D + c8) * wgt[q][j], w1 = *(const f32x4*)(cw + j * D + c8 + 4) * wgt[q][j];
#pragma unroll
                for (int e = 0; e < 4; ++e) {
                    const float wl = e < 2 ? w0[2 * e] : w1[2 * e - 4], wh = e < 2 ? w0[2 * e + 1] : w1[2 * e - 3];
                    accv[2 * e] += wl * __uint_as_float(cg[q][j][e] << 16);
                    accv[2 * e + 1] += wh * __uint_as_float(cg[q][j][e] & 0xffff0000u);
                }
            }
            u32x4 w;
#pragma unroll
            for (int e = 0; e < 4; ++e) w[e] = pk2(__uint_as_float(bg[q][e] << 16) * accv[2 * e], __uint_as_float(bg[q][e] & 0xffff0000u) * accv[2 * e + 1]);
            *(u32x4*)(HS + (size_t)row * D + c8) = w;
        }
    }
}

template <int WIN> DI void poolprep_item(Frame& F, int row, int c4) {
    const float* __restrict__ MOD = (const float*)(F.ws + WS_MOD); bf16_t* __restrict__ HS = (bf16_t*)(F.ws + WS_HS);
    const bf16_t* __restrict__ X = (const bf16_t*)(F.ws + WS_X16);
    const int cd = row_cond(row);
    const int s = row < NCTX ? (row & 255) : ((row - NCTX) & 1023), S = row < NCTX ? 256 : 1024;
    const float* md = MOD + ((size_t)2 * NCOND + cd) * NMOD;
    const f32x4 sh = *(const f32x4*)(md + c4), sc = *(const f32x4*)(md + D + c4) + 1.0f;
    f32x4 xv[WIN]; float wg[WIN]; u32x2 xw[WIN];
#pragma unroll
    for (int j = 0; j < WIN; ++j) { const int ss = s + j - WIN / 2; const bool ok = ss >= 0 && ss < S; wg[j] = ok ? 1.f : 0.f; xw[j] = *(const u32x2*)(X + (size_t)(ok ? row + j - WIN / 2 : row) * D + c4); }
#pragma unroll
    for (int j = 0; j < WIN; ++j) xv[j] = (f32x4){__uint_as_float(xw[j].x << 16), __uint_as_float(xw[j].x & 0xffff0000u), __uint_as_float(xw[j].y << 16), __uint_as_float(xw[j].y & 0xffff0000u)};
    f32x4 sum = (f32x4){0.f, 0.f, 0.f, 0.f}; float cnt = 0.f;
#pragma unroll
    for (int j = 0; j < WIN; ++j) { sum += xv[j] * wg[j]; cnt += wg[j]; }
    const f32x4 p = (sum * (1.0f / cnt) - xv[WIN / 2]) * sc;
    u32x2 w; w.x = pk2(p[0], p[1]); w.y = pk2(p[2], p[3]);
    *(u32x2*)(HS + (size_t)row * D + c4) = w;
}
DI void phase_poolprep(Frame& F) {
    const ItemIter it = thr_items(F, MTOK * 256);
    for (int q = it.start; q < it.per; q += it.stride) {
        const int i = it.base + q;
        const int row = i >> 8, c4 = (i & 255) * 4, g = (i & 255) >> 6;
        if (g == 0) poolprep_item<2>(F, row, c4); else if (g == 1) poolprep_item<4>(F, row, c4); else if (g == 2) poolprep_item<8>(F, row, c4); else poolprep_item<16>(F, row, c4);
    }
}

enum { PK_PRO_A = 0, PK_PRO_B, PK_LN0, PK_UP, PK_DOWN, PK_LN1, PK_ML_IN, PK_S1, PK_S2, PK_S3, PK_OUTPROJ, PK_SC_IN, PK_CONV, PK_POOLPREP, PK_POOLGEMM, PK_F1, PK_F2, PK_OUTPROJ_F, PK_DOWN_F, PK_POOLGEMM_F, PK_UP_DRY, PK_DOWN_DRY, PK_DOWN_FDRY, PK_TAIL_MLIN, PK_TAIL_SCIN, PK_TAIL_F2, PK_COUNT };
template <int SKIND> DI Sched<SKIND> make_sched(Frame& F, const bf16_t* A, int lda, const bf16_t* Bt, int ldb, int n_units, int nN, int nt, int rot) {
    Sched<SKIND> S; S.G = F.G; S.c = (F.bid + rot) % F.G; S.n_units = n_units; S.nN = nN; S.nt = nt; S.A = A; S.Bt = Bt; S.lda = lda; S.ldb = ldb;
    { volatile LAS unsigned* st = (volatile LAS unsigned*)(F.lds + LDS_BYTES - 64); S.rank = (int)__builtin_amdgcn_readfirstlane(st[3]); S.xidx = (int)__builtin_amdgcn_readfirstlane(st[4]); S.uni = (int)__builtin_amdgcn_readfirstlane(st[5]); }
    return S;
}
template <int EKIND> DI Epi<EKIND> make_epi(bf16_t* ob, float* of, int ldc, const float* p0, const float* p1) { Epi<EKIND> E; E.ob = ob; E.of = of; E.ldc = ldc; E.p0 = p0; E.p1 = p1; return E; }

template <int PK> DI void run_kind(Frame& F, int layer) {
    unsigned char* ws = F.ws;
    const bf16_t* H = (const bf16_t*)(ws + WS_H); const bf16_t* HS = (const bf16_t*)(ws + WS_HS);
    if constexpr (PK == PK_PRO_A) phase_prologue_a(F);
    else if constexpr (PK == PK_PRO_B) phase_prologue_b(F);
    else if constexpr (PK == PK_LN0) phase_ln(F, layer, 0, layer == 2 ? 1 : 2, layer == 3 ? F.in[25] : nullptr);
    else if constexpr (PK == PK_LN1) phase_ln(F, layer, 1, 2, nullptr);
    else if constexpr (PK == PK_UP) {
#ifdef PROBE_STAGGER
        if (F.bid & 1) { const unsigned long long t0 = __builtin_amdgcn_s_memrealtime(); while (__builtin_amdgcn_s_memrealtime() - t0 < PROBE_STAGGER) __builtin_amdgcn_s_sleep(8); }
#endif
        auto S = make_sched<K_UPX>(F, H, D, (const bf16_t*)(ws + WS_WT_W1) + (size_t)layer * D * FF, D, 512, 16, 16, 0);
        auto E = make_epi<E_RELU2>((bf16_t*)(ws + WS_H1), nullptr, FF, nullptr, nullptr); gemm_run(F, S, E); }
    else if constexpr (PK == PK_UP_DRY) { auto S = make_sched<K_STD>(F, H, D, (const bf16_t*)(ws + WS_WT_W1) + (size_t)layer * D * FF, D, 512, 16, 16, 0);
        auto E = make_epi<E_NONE>(nullptr, nullptr, FF, nullptr, nullptr); gemm_run(F, S, E); }
    else if constexpr (PK == PK_TAIL_SCIN) tail_sc_in(F);
    else if constexpr (PK == PK_TAIL_F2) { __syncthreads(); tail_f2(F); }
    else if constexpr (PK == PK_TAIL_MLIN) tail_ml_in(F);
    else if constexpr (PK == PK_DOWN_FDRY) {
        EpiLNF E; E.X = (bf16_t*)(ws + WS_X16); E.Xo = (bf16_t*)(ws + WS_L); E.Xf = nullptr; E.H = (bf16_t*)(ws + WS_L + 16 * MiB); E.xb = (float*)(ws + WS_L + 32 * MiB); E.xs = (unsigned long long*)(ws + WS_L + 48 * MiB);
        E.flags = (unsigned*)(ws + WS_CTL) + 32768; E.cnt = (unsigned*)(ws + WS_CTL) + 49152; E.tmo = (unsigned*)(ws + WS_CTL) + CW_TMO;
        const float* MOD = (const float*)(ws + WS_MOD);
        E.mod = MOD + (size_t)layer * NCOND * NMOD; E.bias = nullptr; E.scale = nullptr;
        E.lng = F.in[9] + (size_t)(layer * 2 + 1) * D; E.lnb = F.in[10] + (size_t)(layer * 2 + 1) * D; E.goff = 5 * D;
        E.modn = MOD + (size_t)(layer < 3 ? layer + 1 : 0) * NCOND * NMOD; E.shoff = 0; E.scoff = D; E.epoch = (unsigned)(layer + 1); E.sepoch = E.epoch;
        auto S = make_sched<K_SPLIT2>(F, (const bf16_t*)(ws + WS_H1), FF, (const bf16_t*)(ws + WS_WT_W2) + (size_t)layer * D * FF, FF, 256, 4, 32, 0); gemm_run_lnf(F, S, E); }
    else if constexpr (PK == PK_DOWN_DRY) { auto S = make_sched<K_SPLIT2>(F, (const bf16_t*)(ws + WS_H1), FF, (const bf16_t*)(ws + WS_WT_W2) + (size_t)layer * D * FF, FF, 256, 4, 32, 0);
        auto E = make_epi<E_NONE>(nullptr, nullptr, FF, nullptr, nullptr); gemm_run(F, S, E); }
    else if constexpr (PK == PK_DOWN) { auto S = make_sched<K_SPLIT2>(F, (const bf16_t*)(ws + WS_H1), FF, (const bf16_t*)(ws + WS_WT_W2) + (size_t)layer * D * FF, FF, 256, 4, 32, 0);
        auto E = make_epi<E_F32SPLIT>(nullptr, (float*)(ws + WS_Y), 0, nullptr, nullptr); gemm_run(F, S, E); }
    else if constexpr (PK == PK_ML_IN) { auto S = make_sched<K_STDX>(F, H, D, (const bf16_t*)(ws + WS_WT_MLIN), D, 32 * 13, 13, 16, 0);
        auto E = make_epi<E_ML>((bf16_t*)(ws + WS_QKVO), (float*)(ws + WS_GATES), 0, F.in[15], nullptr); gemm_run(F, S, E); }
    else if constexpr (PK == PK_S1) { phase_s1(F); tail_scan(F, 0); }
    else if constexpr (PK == PK_S2) phase_s2(F);
    else if constexpr (PK == PK_S3) { phase_s3(F); tail_scan(F, 1); }
    else if constexpr (PK == PK_OUTPROJ) { const size_t wo = layer == 0 ? WS_WT_MLOUT : (layer == 1 ? WS_WT_SCOUT : WS_WT_FT);
        auto S = make_sched<K_SPLIT2>(F, HS, D, (const bf16_t*)(ws + wo), D, 256, 4, 8, 0);
        auto E = make_epi<E_F32SPLIT>(nullptr, (float*)(ws + WS_Y), 0, nullptr, nullptr); gemm_run(F, S, E); }
    else if constexpr (PK == PK_SC_IN) { auto S = make_sched<K_STDX>(F, H, D, (const bf16_t*)(ws + WS_WT_SCIN), D, 32 * 12, 12, 16, 0);
        auto E = make_epi<E_SC>((bf16_t*)(ws + WS_QKVO), nullptr, 3072, nullptr, nullptr); gemm_run(F, S, E); }
    else if constexpr (PK == PK_CONV) phase_conv(F);
    else if constexpr (PK == PK_POOLPREP) phase_poolprep(F);
    else if constexpr (PK == PK_POOLGEMM) { auto S = make_sched<K_POOL>(F, HS, D, (const bf16_t*)(ws + WS_WT_PL), 256, 128, 4, 4, 0);
        auto E = make_epi<E_POOL>(nullptr, (float*)(ws + WS_Y), 0, F.in[22], F.in[23]); gemm_run(F, S, E); }
    else if constexpr (PK == PK_F1) { auto S = make_sched<K_F1>(F, (const bf16_t*)(ws + WS_WC), 256, H, D, 256, 32, 4, 0);
        auto E = make_epi<E_F1>((bf16_t*)(ws + WS_QKVO), nullptr, 0, nullptr, nullptr); gemm_run(F, S, E); }
    else if constexpr (PK == PK_OUTPROJ_F || PK == PK_DOWN_F || PK == PK_POOLGEMM_F) {
        EpiLNF E; E.X = (bf16_t*)(ws + WS_X16); E.Xo = E.X; E.Xf = nullptr; E.H = (bf16_t*)(ws + WS_H); E.xb = (float*)(ws + WS_Y); E.xs = (unsigned long long*)(ws + WS_XS);
        E.flags = (unsigned*)(ws + WS_CTL) + CW_FLAGS; E.cnt = (unsigned*)(ws + WS_CTL) + CW_CNT; E.tmo = (unsigned*)(ws + WS_CTL) + CW_TMO;
        const float* MOD = (const float*)(ws + WS_MOD);
        E.mod = MOD + (size_t)layer * NCOND * NMOD; E.bias = nullptr; E.scale = nullptr;
        constexpr int sub = (PK == PK_DOWN_F) ? 1 : 0;
        E.lng = F.in[9] + (size_t)(layer * 2 + sub) * D; E.lnb = F.in[10] + (size_t)(layer * 2 + sub) * D;
        E.goff = sub == 0 ? 2 * D : 5 * D;
        if (sub == 0) { E.modn = MOD + (size_t)layer * NCOND * NMOD; E.shoff = 3 * D; E.scoff = 4 * D; }
        else { E.modn = layer < 3 ? MOD + (size_t)(layer + 1) * NCOND * NMOD : nullptr; E.shoff = 0; E.scoff = D; if (layer == 3) E.Xf = F.out; }
        E.epoch = (unsigned)(layer * 2 + sub + 1); E.sepoch = E.epoch;
        if constexpr (PK == PK_OUTPROJ_F) { const size_t wo = layer == 0 ? WS_WT_MLOUT : (layer == 1 ? WS_WT_SCOUT : WS_WT_FT); if (layer == 3) E.bias = F.in[25];
            auto S = make_sched<K_SPLITX>(F, HS, D, (const bf16_t*)(ws + wo), D, 256, 4, 8, 0); gemm_run_lnf(F, S, E); }
        else if constexpr (PK == PK_DOWN_F) { if (layer == 2) E.X = (bf16_t*)(ws + WS_HS);
            auto S = make_sched<K_SPLITX>(F, (const bf16_t*)(ws + WS_H1), FF, (const bf16_t*)(ws + WS_WT_W2) + (size_t)layer * D * FF, FF, 256, 4, 32, 0); gemm_run_lnf(F, S, E); }
        else { E.bias = F.in[22]; E.scale = F.in[23];
            E.Xo = (bf16_t*)(ws + WS_HS);
            auto S = make_sched<K_POOLX>(F, HS, D, (const bf16_t*)(ws + WS_WT_PL), 256, 256, 4, 2, 0);
            pool_gemm_lnf(F, S, E, (const bf16_t*)(ws + WS_X16), MOD + (size_t)2 * NCOND * NMOD); }
    }
    else { auto E = make_epi<E_F2>((bf16_t*)(ws + WS_HS), nullptr, 0, nullptr, nullptr);
        { auto S = make_sched<K_F2L>(F, (const bf16_t*)(ws + WS_T1024), 2048, (const bf16_t*)(ws + WS_QKVO) + (size_t)16 * 1024 * 512, 2048, 128, 4, 32, 0); gemm_run(F, S, E); }
        __syncthreads();
        { auto S = make_sched<K_F2C>(F, (const bf16_t*)(ws + WS_T256), 512, (const bf16_t*)(ws + WS_QKVO), 512, 64, 4, 8, (F.G > 128 ? F.G - 128 : 0)); gemm_run(F, S, E); }
        }
}

DI void frame_init(Frame& F, const Args& args, unsigned char* lds_raw) {
    F.lds = (LAS unsigned char*)lds_raw;
    F.tid = threadIdx.x; F.lane = F.tid & 63; F.wave = __builtin_amdgcn_readfirstlane(F.tid >> 6);
    F.G = gridDim.x; F.bid = blockIdx.x;
    F.in = (const float* const*)__builtin_amdgcn_kernarg_segment_ptr();
    F.out = args.out; F.ws = args.ws; F.uni = 0; F.xidx = 0; F.rank = 0;
}

DI void frame_launder(Frame& F, const Args& args, unsigned char* lds_raw) {
    size_t z = 0; int p_tid = threadIdx.x, p_bid = blockIdx.x, p_g = gridDim.x;
    asm volatile("" : "+s"(z), "+v"(p_tid), "+s"(p_bid), "+s"(p_g));
    F.in = (const float* const*)((const char*)__builtin_amdgcn_kernarg_segment_ptr() + z); F.out = (float*)((char*)args.out + z); F.ws = args.ws + z;
    F.tid = p_tid; F.lane = p_tid & 63; F.wave = __builtin_amdgcn_readfirstlane(p_tid >> 6); F.bid = p_bid; F.G = p_g;
    F.lds = (LAS unsigned char*)lds_raw;
    { volatile LAS unsigned* st = (volatile LAS unsigned*)(F.lds + LDS_BYTES - 64); F.rank = (int)__builtin_amdgcn_readfirstlane(st[3]); F.xidx = (int)__builtin_amdgcn_readfirstlane(st[4]); F.uni = (int)__builtin_amdgcn_readfirstlane(st[5]); }
}
__global__ void __launch_bounds__(NTHR, 2) mega_fwd(Args args) {
    extern __shared__ __attribute__((aligned(16))) unsigned char lds_raw[];
    Frame F; frame_init(F, args, lds_raw);
    volatile LAS unsigned* MISC = (volatile LAS unsigned*)(F.lds + LDS_BYTES - 64);
    if (F.tid < 16) MISC[F.tid] = 0u;
    __syncthreads();
    (void)xcd_barrier_post((unsigned*)(args.ws + WS_CTL) + CW_BAR, MISC);
#ifndef DBL_MASK
#define DBL_MASK 0u
#endif
#define PHASE(PK, layer) do { frame_launder(F, args, lds_raw); run_kind<PK>(F, (layer)); \
        if ((DBL_MASK >> (PK)) & 1u) { SEAM(); frame_launder(F, args, lds_raw); run_kind<PK>(F, (layer)); } } while (0)
#ifdef PROBE_DOWNFDRY
#define PROBE_DDRY(l) do { PHASE(PK_DOWN_FDRY, l); SEAM(); } while (0)
#elif defined(PROBE_DOWNDRY)
#define PROBE_DDRY(l) do { PHASE(PK_DOWN_DRY, l); SEAM(); } while (0)
#else
#define PROBE_DDRY(l) do { } while (0)
#endif
#ifdef PROBE_UPDRY
#define PROBE_DRY(l) do { PHASE(PK_UP_DRY, l); SEAM(); } while (0)
#else
#define PROBE_DRY(l) do { } while (0)
#endif
#define SEAM_L() do { frame_launder(F, args, lds_raw); XcdBarrier b_; b_.bar = (unsigned*)(F.ws + WS_CTL) + CW_BAR; b_.x = xb_xcc_id(); b_.st = (volatile LAS unsigned*)(F.lds + LDS_BYTES - 64); \
        if (__builtin_amdgcn_readfirstlane(b_.st[5])) xcc_local_barrier(b_); else xcd_barrier(b_); } while (0)
#define SEAM() do { frame_launder(F, args, lds_raw); XcdBarrier b_; b_.bar = (unsigned*)(F.ws + WS_CTL) + CW_BAR; b_.x = xb_xcc_id(); b_.st = (volatile LAS unsigned*)(F.lds + LDS_BYTES - 64); xcd_barrier(b_); } while (0)
    PHASE(PK_PRO_A, 0); SEAM();
    PHASE(PK_PRO_B, 0); SEAM_L();
    PHASE(PK_ML_IN, 0); PHASE(PK_TAIL_MLIN, 0); SEAM_L(); PHASE(PK_S1, 0); SEAM_L(); PHASE(PK_S2, 0); SEAM_L(); PHASE(PK_S3, 0); SEAM(); PHASE(PK_OUTPROJ_F, 0); SEAM_L();
    PROBE_DRY(0); PHASE(PK_UP, 0); SEAM_L(); PROBE_DDRY(0); PHASE(PK_DOWN_F, 0); SEAM();
    PHASE(PK_SC_IN, 1); PHASE(PK_TAIL_SCIN, 1); SEAM_L(); PHASE(PK_CONV, 1); SEAM(); PHASE(PK_OUTPROJ_F, 1); SEAM_L();
    PROBE_DRY(1); PHASE(PK_UP, 1); SEAM_L(); PROBE_DDRY(1); PHASE(PK_DOWN_F, 1); SEAM_L();
    PHASE(PK_POOLGEMM_F, 2); SEAM_L();
    PROBE_DRY(2); PHASE(PK_UP, 2); SEAM_L(); PROBE_DDRY(2); PHASE(PK_DOWN_F, 2); SEAM_L();
    PHASE(PK_F1, 3); SEAM_L(); PHASE(PK_F2, 3); PHASE(PK_TAIL_F2, 3); SEAM(); PHASE(PK_OUTPROJ_F, 3); SEAM_L();
    PROBE_DRY(3); PHASE(PK_UP, 3); SEAM_L(); PROBE_DDRY(3); PHASE(PK_DOWN_F, 3);
#undef PHASE
#undef SEAM
}

extern "C" void kernel_launch(void* const* d_in, const int* in_sizes, int n_in, void* d_out, int out_size, void* d_ws, size_t ws_size, hipStream_t stream) {
    static int grid = 0;
    Args a{};
    if (grid == 0) {
        if (n_in != 26 || out_size != 10502400 || ws_size < WS_END) { fprintf(stderr, "kernel_launch: unexpected shapes (n_in %d out %d ws %zu)\n", n_in, out_size, ws_size); grid = -1; return; }
        int dev = 0, cus = 0, per_cu = 0;
        if (hipGetDevice(&dev) != hipSuccess || hipDeviceGetAttribute(&cus, hipDeviceAttributeMultiprocessorCount, dev) != hipSuccess) { grid = -1; return; }
        if (hipFuncSetAttribute((const void*)mega_fwd, hipFuncAttributeMaxDynamicSharedMemorySize, LDS_BYTES) != hipSuccess) { fprintf(stderr, "kernel_launch: hipFuncSetAttribute failed\n"); grid = -1; return; }
        if (hipOccupancyMaxActiveBlocksPerMultiprocessor(&per_cu, (const void*)mega_fwd, NTHR, LDS_BYTES) != hipSuccess || per_cu < 1) { fprintf(stderr, "kernel_launch: occupancy query says %d blocks per CU\n", per_cu); (void)hipGetLastError(); grid = -1; return; }
        if (cus < 256) { fprintf(stderr, "kernel_launch: this build needs 256 CUs (one 256x256 unit per workgroup in the fused-LayerNorm GEMM phases); device has %d\n", cus); grid = -1; return; }
        grid = 256;
    }
    if (grid < 0) return;
    for (int i = 0; i < 26; ++i) a.in[i] = (const float*)d_in[i];
    a.out = (float*)d_out; a.ws = (unsigned char*)d_ws;
    (void)hipMemsetAsync((char*)d_ws + WS_CTL, 0, CTL_ZERO_BYTES, stream);
    a.ph_lo = 0; a.ph_hi = 0;
    void* kargs[] = {&a};
    hipError_t e = hipLaunchCooperativeKernel((const void*)mega_fwd, dim3(grid), dim3(NTHR), kargs, LDS_BYTES, stream);
    if (e != hipSuccess) fprintf(stderr, "kernel_launch: cooperative launch failed: %s (grid %d)\n", hipGetErrorString(e), grid);
}
```
